# Optimizing an MI355X kernel written in HIP

```python
import jax, jax.numpy as jnp
from jax import lax
import numpy as np

D_MODEL = 2048
BATCH = 4
SEQ = 8192
DEPTH = 4

D_MIX = D_MODEL
D_HALF = D_MIX // 2
D_FF = 5632
CONV_W = 4
LRU_HEADS = 8
LRU_HDIM = D_HALF // LRU_HEADS
LRU_C = 8.0
GLA_HEADS = 4
GLA_DK = D_HALF // 2 // GLA_HEADS
GLA_DV = D_HALF // GLA_HEADS
GLA_RANK = 16
GLA_TAU = 16.0
GLA_CHUNK = 64
MLSTM_HEADS = 4
MLSTM_HDIM = D_HALF // MLSTM_HEADS
MLSTM_BLOCK = 4
MLSTM_CHUNK = 64
POOL_WINDOWS = (2, 4, 8, 16)
POOL_GROUPS = 4
POOL_GDIM = D_HALF // POOL_GROUPS
EPS = 1e-6

EVEN_SPLITS = (D_HALF, D_HALF, GLA_HEADS * GLA_DK, GLA_HEADS * GLA_DK,
               GLA_HEADS * GLA_DV, GLA_HEADS * GLA_DV, GLA_RANK)
EVEN_IN = sum(EVEN_SPLITS)
ODD_SPLITS = (D_HALF, D_HALF, D_HALF)
ODD_IN = sum(ODD_SPLITS)
N_EVEN = (DEPTH + 1) // 2
N_ODD = DEPTH // 2

kernel_name = 'hybrid_rglru_gla_mlstm_pool_macaron'


def split_cols(p, sizes):
    idx, acc = [], 0
    for s in sizes[:-1]:
        acc += s
        idx.append(acc)
    return jnp.split(p, idx, axis=-1)


def rmsnorm(x, g):
    xf = x.astype(jnp.float32)
    y = xf * lax.rsqrt(jnp.mean(xf * xf, axis=-1, keepdims=True) + EPS)
    return (y * g.astype(jnp.float32)).astype(x.dtype)


def head_rmsnorm(h, w):
    B, S, H, d = h.shape
    hf = h.astype(jnp.float32)
    hf = hf * lax.rsqrt(jnp.mean(hf * hf, axis=-1, keepdims=True) + EPS)
    return (hf.reshape(B, S, H * d) * w.astype(jnp.float32)).astype(h.dtype)


def swiglu(x, wg, wu, wd):
    return (jax.nn.silu(x @ wg) * (x @ wu)) @ wd


def causal_dwconv(x, w, b):
    C = x.shape[-1]
    y = lax.conv_general_dilated(x, w[:, None, :], window_strides=(1,),
                                 padding=[(w.shape[0] - 1, 0)],
                                 dimension_numbers=('NWC', 'WIO', 'NWC'),
                                 feature_group_count=C)
    return y + b


def blockdiag(x, w):
    B, S, _ = x.shape
    nb, bs, _ = w.shape
    return jnp.einsum('bsgi,gij->bsgj', x.reshape(B, S, nb, bs), w).reshape(B, S, nb * bs)


def rg_lru(xc, wa, ba, wx, bx, lam):
    r = jax.nn.sigmoid((blockdiag(xc, wa) + ba).astype(jnp.float32))
    i = jax.nn.sigmoid((blockdiag(xc, wx) + bx).astype(jnp.float32))
    log_a = -LRU_C * r * jax.nn.softplus(-lam.astype(jnp.float32))
    a = jnp.exp(log_a)
    b_in = jnp.sqrt(-jnp.expm1(2.0 * log_a)) * (i * xc.astype(jnp.float32))

    def combine(left, right):
        a1, b1 = left
        a2, b2 = right
        return a1 * a2, a2 * b1 + b2

    _, h = lax.associative_scan(combine, (a, b_in), axis=1)
    return h


def gla_chunked(q, k, v, log_alpha):
    B, S, H, dk = q.shape
    dv = v.shape[-1]
    L = GLA_CHUNK
    N = S // L

    def to_chunks(t):
        return t.astype(jnp.float32).reshape(B, N, L, H, t.shape[-1]).transpose(1, 0, 3, 2, 4)

    qc = to_chunks(q) * (dk ** -0.5)
    kc, vc, gc = to_chunks(k), to_chunks(v), to_chunks(log_alpha)
    causal = jnp.tril(jnp.ones((L, L), dtype=bool))

    def step(state, inp):
        qi, ki, vi, gi = inp
        bcum = jnp.cumsum(gi, axis=2)
        q_dec = qi * jnp.exp(bcum)
        k_inv = ki * jnp.exp(-bcum)
        scores = jnp.where(causal, jnp.einsum('bhtd,bhsd->bhts', q_dec, k_inv), 0.0)
        o = (jnp.einsum('bhts,bhsv->bhtv', scores, vi)
             + jnp.einsum('bhtd,bhdv->bhtv', q_dec, state))
        b_last = bcum[:, :, -1:, :]
        k_dec = ki * jnp.exp(b_last - bcum)
        new_state = (jnp.exp(b_last[:, :, 0, :])[..., None] * state
                     + jnp.einsum('bhsd,bhsv->bhdv', k_dec, vi))
        return new_state, o

    s0 = jnp.zeros((B, H, dk, dv), jnp.float32)
    _, o = lax.scan(step, s0, (qc, kc, vc, gc))
    return o.transpose(1, 0, 3, 2, 4).reshape(B, S, H, dv)


def mlstm_chunked(q, k, v, i_pre, f_pre):
    B, S, H, dh = q.shape
    L = MLSTM_CHUNK
    N = S // L

    def to_chunks(t):
        return t.astype(jnp.float32).reshape(B, N, L, H, dh).transpose(1, 0, 3, 2, 4)

    def gate_chunks(t):
        return t.astype(jnp.float32).reshape(B, N, L, H).transpose(1, 0, 3, 2)

    qc, vc = to_chunks(q), to_chunks(v)
    kc = to_chunks(k) * (dh ** -0.5)
    ic = gate_chunks(i_pre)
    lfc = jax.nn.log_sigmoid(gate_chunks(f_pre))
    causal = jnp.tril(jnp.ones((L, L), dtype=bool))

    def step(carry, inp):
        C, n, m = carry
        qi, ki, vi, ii, lfi = inp
        bcum = jnp.cumsum(lfi, axis=-1)
        D = bcum[..., :, None] - bcum[..., None, :] + ii[..., None, :]
        D = jnp.where(causal, D, -jnp.inf)
        inter = bcum + m[..., None]
        m_t = jnp.maximum(inter, jnp.max(D, axis=-1))
        W = jnp.exp(D - m_t[..., None])
        inter_w = jnp.exp(inter - m_t)
        qk = jnp.einsum('bhtd,bhsd->bhts', qi, ki) * W
        num = (jnp.einsum('bhts,bhsv->bhtv', qk, vi)
               + inter_w[..., None] * jnp.einsum('bhtd,bhvd->bhtv', qi, C))
        den = jnp.sum(qk, axis=-1) + inter_w * jnp.einsum('bhtd,bhd->bht', qi, n)
        h = num / jnp.maximum(jnp.abs(den), jnp.exp(-m_t))[..., None]
        b_L = bcum[..., -1]
        g = b_L[..., None] - bcum + ii
        m_new = jnp.maximum(b_L + m, jnp.max(g, axis=-1))
        decay = jnp.exp(b_L + m - m_new)
        w_s = jnp.exp(g - m_new[..., None])
        C_new = decay[..., None, None] * C + jnp.einsum('bhs,bhsv,bhsd->bhvd', w_s, vi, ki)
        n_new = decay[..., None] * n + jnp.einsum('bhs,bhsd->bhd', w_s, ki)
        return (C_new, n_new, m_new), h

    init = (jnp.zeros((B, H, dh, dh), jnp.float32),
            jnp.zeros((B, H, dh), jnp.float32),
            jnp.zeros((B, H), jnp.float32))
    _, h = lax.scan(step, init, (qc, kc, vc, ic, lfc))
    return h.transpose(1, 0, 3, 2, 4).reshape(B, S, H, dh)


def multiscale_pool(u, w, scale):
    B, S, _ = u.shape
    ug = u.astype(jnp.float32).reshape(B, S, POOL_GROUPS, POOL_GDIM)
    c0 = jnp.concatenate([jnp.zeros((B, 1, POOL_GROUPS, POOL_GDIM), jnp.float32),
                          jnp.cumsum(ug, axis=1)], axis=1)
    pos = jnp.arange(S)
    outs = []
    for gi, win in enumerate(POOL_WINDOWS):
        cg = c0[:, :, gi]
        lag = jnp.pad(cg, ((0, 0), (win - 1, 0), (0, 0)))[:, :S]
        cnt = jnp.minimum(pos + 1, win).astype(jnp.float32)[None, :, None]
        outs.append((cg[:, 1:] - lag) / cnt - ug[:, :, gi])
    p = jnp.stack(outs, axis=2)
    y = jnp.einsum('bsgi,gij->bsgj', p, w.astype(jnp.float32)).reshape(B, S, D_HALF)
    return (y * scale.astype(jnp.float32)).astype(u.dtype)


def even_mixer(u, w_in, w_out, conv_w, conv_b, wa, ba, wx, bx, lam, g_up, g_b, gla_norm):
    B, S, _ = u.shape
    xb, yb, q, k, v, r, glr = split_cols(u @ w_in, EVEN_SPLITS)
    xc = causal_dwconv(xb, conv_w, conv_b)
    a_out = (rg_lru(xc, wa, ba, wx, bx, lam) * jax.nn.gelu(yb.astype(jnp.float32))).astype(u.dtype)
    log_alpha = jax.nn.log_sigmoid((glr @ g_up + g_b).astype(jnp.float32)) / GLA_TAU
    o = gla_chunked(q.reshape(B, S, GLA_HEADS, GLA_DK), k.reshape(B, S, GLA_HEADS, GLA_DK),
                    v.reshape(B, S, GLA_HEADS, GLA_DV), log_alpha.reshape(B, S, GLA_HEADS, GLA_DK))
    b_out = head_rmsnorm(o.astype(u.dtype), gla_norm) * jax.nn.silu(r)
    return jnp.concatenate([a_out, b_out], axis=-1) @ w_out


def odd_mixer(u, w_in, w_out, conv_w, conv_b, wq, wk, wv, w_if, b_if, skip, mnorm, pool_w, pool_scale):
    B, S, _ = u.shape
    xm, z, pu = split_cols(u @ w_in, ODD_SPLITS)
    xc = jax.nn.silu(causal_dwconv(xm, conv_w, conv_b))
    q = blockdiag(xc, wq)
    k = blockdiag(xc, wk)
    v = blockdiag(xm, wv)
    gates = jnp.concatenate([q, k, v], axis=-1) @ w_if + b_if
    shp = (B, S, MLSTM_HEADS, MLSTM_HDIM)
    h = mlstm_chunked(q.reshape(shp), k.reshape(shp), v.reshape(shp),
                      gates[..., :MLSTM_HEADS], gates[..., MLSTM_HEADS:])
    c_out = jax.nn.sigmoid(z) * (head_rmsnorm(h.astype(u.dtype), mnorm) + skip * xc)
    d_out = multiscale_pool(pu, pool_w, pool_scale)
    return jnp.concatenate([c_out, d_out], axis=-1) @ w_out


def setup_inputs(seed: int = 0) -> dict:
    key = jax.random.key(seed)
    ks = jax.random.split(key, 30)
    f32 = jnp.float32

    def nrm(k, shape, scale):
        return jax.random.normal(k, shape, f32) * scale

    a0 = jax.random.uniform(ks[13], (N_EVEN, D_HALF), f32, 0.9, 0.999)
    p = a0 ** (1.0 / LRU_C)
    lru_lambda = jnp.log(p) - jnp.log1p(-p)
    f_bias = jnp.broadcast_to(jnp.linspace(3.0, 6.0, MLSTM_HEADS, dtype=f32), (N_ODD, MLSTM_HEADS))
    b_if = jnp.concatenate([nrm(ks[25], (N_ODD, MLSTM_HEADS), 0.1),
                            f_bias + nrm(ks[26], (N_ODD, MLSTM_HEADS), 0.1)], axis=-1)
    nb = D_HALF // MLSTM_BLOCK
    return {
        'x': nrm(ks[0], (BATCH, SEQ, D_MODEL), 1.0),
        'norm_g': 1.0 + nrm(ks[1], (DEPTH, 6, D_MODEL), 0.02),
        'ffn_wg': nrm(ks[2], (DEPTH, 2, D_MODEL, D_FF), D_MODEL ** -0.5),
        'ffn_wu': nrm(ks[3], (DEPTH, 2, D_MODEL, D_FF), D_MODEL ** -0.5),
        'ffn_wd': nrm(ks[4], (DEPTH, 2, D_FF, D_MODEL), D_FF ** -0.5),
        'ev_w_in': nrm(ks[5], (N_EVEN, D_MODEL, EVEN_IN), D_MODEL ** -0.5),
        'ev_w_out': nrm(ks[6], (N_EVEN, D_MIX, D_MODEL), D_MIX ** -0.5),
        'lru_conv_w': nrm(ks[7], (N_EVEN, CONV_W, D_HALF), CONV_W ** -0.5),
        'lru_conv_b': nrm(ks[8], (N_EVEN, D_HALF), 0.02),
        'lru_wa': nrm(ks[9], (N_EVEN, LRU_HEADS, LRU_HDIM, LRU_HDIM), LRU_HDIM ** -0.5),
        'lru_ba': nrm(ks[10], (N_EVEN, D_HALF), 0.02),
        'lru_wx': nrm(ks[11], (N_EVEN, LRU_HEADS, LRU_HDIM, LRU_HDIM), LRU_HDIM ** -0.5),
        'lru_bx': nrm(ks[12], (N_EVEN, D_HALF), 0.02),
        'lru_lambda': lru_lambda,
        'gla_w_gate': nrm(ks[14], (N_EVEN, GLA_RANK, GLA_HEADS * GLA_DK), GLA_RANK ** -0.5),
        'gla_b_gate': nrm(ks[15], (N_EVEN, GLA_HEADS * GLA_DK), 0.02),
        'gla_norm': 1.0 + nrm(ks[16], (N_EVEN, GLA_HEADS * GLA_DV), 0.02),
        'od_w_in': nrm(ks[17], (N_ODD, D_MODEL, ODD_IN), D_MODEL ** -0.5),
        'od_w_out': nrm(ks[18], (N_ODD, D_MIX, D_MODEL), D_MIX ** -0.5),
        'mlstm_conv_w': nrm(ks[19], (N_ODD, CONV_W, D_HALF), CONV_W ** -0.5),
        'mlstm_conv_b': nrm(ks[20], (N_ODD, D_HALF), 0.02),
        'mlstm_wq': nrm(ks[21], (N_ODD, nb, MLSTM_BLOCK, MLSTM_BLOCK), MLSTM_BLOCK ** -0.5),
        'mlstm_wk': nrm(ks[22], (N_ODD, nb, MLSTM_BLOCK, MLSTM_BLOCK), MLSTM_BLOCK ** -0.5),
        'mlstm_wv': nrm(ks[23], (N_ODD, nb, MLSTM_BLOCK, MLSTM_BLOCK), MLSTM_BLOCK ** -0.5),
        'mlstm_w_if': nrm(ks[24], (N_ODD, 3 * D_HALF, 2 * MLSTM_HEADS), (3 * D_HALF) ** -0.5),
        'mlstm_b_if': b_if,
        'mlstm_skip': 1.0 + nrm(ks[27], (N_ODD, D_HALF), 0.02),
        'mlstm_norm': 1.0 + nrm(ks[28], (N_ODD, D_HALF), 0.02),
        'pool_w': nrm(ks[29], (N_ODD, POOL_GROUPS, POOL_GDIM, POOL_GDIM), POOL_GDIM ** -0.5),
        'pool_scale': 1.0 + nrm(jax.random.fold_in(ks[29], 1), (N_ODD, D_HALF), 0.02),
    }


def reference(x, norm_g, ffn_wg, ffn_wu, ffn_wd, ev_w_in, ev_w_out, lru_conv_w, lru_conv_b,
              lru_wa, lru_ba, lru_wx, lru_bx, lru_lambda, gla_w_gate, gla_b_gate, gla_norm,
              od_w_in, od_w_out, mlstm_conv_w, mlstm_conv_b, mlstm_wq, mlstm_wk, mlstm_wv,
              mlstm_w_if, mlstm_b_if, mlstm_skip, mlstm_norm, pool_w, pool_scale):
    for layer in range(DEPTH):
        g = norm_g[layer]
        j = layer // 2
        h = swiglu(rmsnorm(x, g[0]), ffn_wg[layer, 0], ffn_wu[layer, 0], ffn_wd[layer, 0])
        x = x + 0.5 * rmsnorm(h, g[1])
        u = rmsnorm(x, g[2])
        if layer % 2 == 0:
            m = even_mixer(u, ev_w_in[j], ev_w_out[j], lru_conv_w[j], lru_conv_b[j],
                           lru_wa[j], lru_ba[j], lru_wx[j], lru_bx[j], lru_lambda[j],
                           gla_w_gate[j], gla_b_gate[j], gla_norm[j])
        else:
            m = odd_mixer(u, od_w_in[j], od_w_out[j], mlstm_conv_w[j], mlstm_conv_b[j],
                          mlstm_wq[j], mlstm_wk[j], mlstm_wv[j], mlstm_w_if[j], mlstm_b_if[j],
                          mlstm_skip[j], mlstm_norm[j], pool_w[j], pool_scale[j])
        x = x + rmsnorm(m, g[3])
        h = swiglu(rmsnorm(x, g[4]), ffn_wg[layer, 1], ffn_wu[layer, 1], ffn_wd[layer, 1])
        x = x + 0.5 * rmsnorm(h, g[5])
    return x
```

```cpp
#include <hip/hip_runtime.h>
#include <cstdio>
#include <cstdint>
namespace pg8 {
#define PG8_LAS __attribute__((address_space(3)))
typedef unsigned short bf16_t;
typedef short bf16x8 __attribute__((ext_vector_type(8)));
typedef float f32x4 __attribute__((ext_vector_type(4)));
typedef unsigned u32x4 __attribute__((ext_vector_type(4)));
constexpr int BM = 256, BK = 64, HALF = 128, HTB = HALF * BK * 2  , STAGE_BYTES = 8 * HTB, NXCD = 8, WGM = 8;

__host__ __device__ __forceinline__ int lds_byte(int r, int c) { const int st = (r >> 4) * 2 + (c >> 5), rr = r & 15, cc = c & 31, ob = rr * 64 + cc * 2; return st * 1024 + (ob ^ (((ob >> 9) & 1) << 5)); }
__host__ __device__ __forceinline__ void stage_rc(int b, int& R, int& C) { const int st = b / 1024, sb = b % 1024, swz = sb ^ (((sb >> 9) & 1) << 5); R = (st >> 1) * 16 + swz / 64; C = (st & 1) * 32 + (swz % 64) / 2; }
__host__ __device__ __forceinline__ int perm32(int rho) { const int n = rho >> 4, i = rho & 15; return 8 * (i >> 2) + 4 * n + (i & 3); }

struct Unit { int pm, pn; };
struct Gemm { const bf16_t* A; const bf16_t* Bt; int M, N, K; };

struct StaticOrder {
    int nM, nN, nwg, G, c;
    __host__ __device__ void init(int M, int N, int G_, int c_) { nM = M / BM; nN = N / BM; nwg = nM * nN; G = G_; c = c_; }
    __host__ __device__ bool next(int i, Unit& u) const {
        const long L = (long)i * G + c; if (L >= nwg) return false;
        int wgid = (int)L; { const int q = nwg / NXCD, r = nwg % NXCD, xcd = wgid % NXCD, off = wgid / NXCD; wgid = (xcd < r ? xcd * (q + 1) : r * (q + 1) + (xcd - r) * q) + off; }
        const int nig = WGM * nN, gid = wgid / nig, fm = gid * WGM, gsz = (nM - fm) < WGM ? (nM - fm) : WGM;
        u.pm = fm + ((wgid % nig) % gsz); u.pn = (wgid % nig) / gsz; return true;
    }
    __device__ __forceinline__ void a_ready(const Unit&) const {}
    __device__ __forceinline__ void done(const Unit&) const {}
};

__device__ __forceinline__ unsigned cvt_pk_bf16(float lo, float hi) { unsigned r; asm volatile("v_cvt_pk_bf16_f32 %0, %1, %2" : "=v"(r) : "v"(lo), "v"(hi)); return r; }
typedef float f32x2 __attribute__((ext_vector_type(2)));
__device__ __forceinline__ float silu_f(float x) { return x * __builtin_amdgcn_rcpf(1.0f + __expf(-x)); }
struct EpiSwiglu {
    static constexpr bool PERM = true, AFTER_DRAIN = false;
    bf16_t* O; int ldc;
    __device__ __forceinline__ void operator()(const f32x4 (&acc)[2][2][4][2], const Unit& u, int wr, int wc, int fr, int fq) const {
        const int row0 = u.pm * BM + wr * 64 + fr, col0 = u.pn * HALF + wc * 32 + 8 * fq;
#pragma unroll
        for (int ai = 0; ai < 2; ++ai)
#pragma unroll
            for (int m = 0; m < 4; ++m) { bf16_t* rowp = O + (size_t)(row0 + ai * HALF + m * 16) * ldc + col0;
                const f32x4 g0 = acc[ai][0][m][0], g1 = acc[ai][0][m][1], u0 = acc[ai][1][m][0], u1 = acc[ai][1][m][1];
                u32x4 w; w.x = cvt_pk_bf16(silu_f(g0[0]) * u0[0], silu_f(g0[1]) * u0[1]); w.y = cvt_pk_bf16(silu_f(g0[2]) * u0[2], silu_f(g0[3]) * u0[3]);
                w.z = cvt_pk_bf16(silu_f(g1[0]) * u1[0], silu_f(g1[1]) * u1[1]); w.w = cvt_pk_bf16(silu_f(g1[2]) * u1[2], silu_f(g1[3]) * u1[3]);
                *(u32x4*)rowp = w; }
    }
};
struct EpiBf16P {
    static constexpr bool PERM = true, AFTER_DRAIN = false;
    bf16_t* O; int ldc;
    __device__ __forceinline__ void operator()(const f32x4 (&acc)[2][2][4][2], const Unit& u, int wr, int wc, int fr, int fq) const {
        const int row0 = u.pm * BM + wr * 64 + fr, col0 = u.pn * BM + wc * 32 + 8 * fq;
#pragma unroll
        for (int ai = 0; ai < 2; ++ai)
#pragma unroll
            for (int m = 0; m < 4; ++m) { bf16_t* rowp = O + (size_t)(row0 + ai * HALF + m * 16) * ldc + col0;
#pragma unroll
                for (int bj = 0; bj < 2; ++bj) { const f32x4 v0 = acc[ai][bj][m][0], v1 = acc[ai][bj][m][1];
                    u32x4 w; w.x = cvt_pk_bf16(v0[0], v0[1]); w.y = cvt_pk_bf16(v0[2], v0[3]); w.z = cvt_pk_bf16(v1[0], v1[1]); w.w = cvt_pk_bf16(v1[2], v1[3]);
                    *(u32x4*)(rowp + bj * HALF) = w; } }
    }
};

template <class Epi, class Sched, bool ALIGN_EPI = false, bool SP2 = false>
__device__ __forceinline__ void gemm_phase(PG8_LAS unsigned char* lds, const Gemm g, const Sched& S, const Epi& E) {
    const int tid = threadIdx.x, wid = __builtin_amdgcn_readfirstlane(tid >> 6), lane = tid & 63, wr = wid >> 2, wc = wid & 3, fr = lane & 15, fq = lane >> 4;
    const int K = g.K, nt = K / BK;
    unsigned voffA[2], voffB[2];
#pragma unroll
    for (int i = 0; i < 2; ++i) { int R, C; stage_rc(tid * 16 + i * 8192, R, C); const int Rb = Epi::PERM ? ((R & ~31) + perm32(R & 31)) : R;
        voffA[i] = (unsigned)(R * K + C) * 2u; voffB[i] = (unsigned)(Rb * K + C) * 2u; }
    const size_t kstep = (size_t)(BK * 2);
    const size_t hstep = (size_t)HALF * K * 2;
    const size_t tstep = 2 * hstep;
    const unsigned ldsw = (unsigned)wid * 1024u;
    const int aoff = lds_byte(wr * 64 + fr, fq * 8), boff = lds_byte(wc * 32 + fr, fq * 8);
#define PG8_SA(b, h) (((b) * 2 + (h)) * HTB)
#define PG8_SB(b, h) ((4 + (b) * 2 + (h)) * HTB)
#define PG8_STAGE(bufoff, gbase, voff) do { _Pragma("unroll") for (int _i = 0; _i < 2; ++_i) \
        __builtin_amdgcn_global_load_lds((const unsigned*)((const char*)(gbase) + (voff)[_i]), (PG8_LAS unsigned*)(lds + (bufoff) + ldsw + _i * 8192), 16, 0, 0); } while (0)
#define PG8_LDA(dst, b, h) do { _Pragma("unroll") for (int m = 0; m < 4; ++m) _Pragma("unroll") for (int k = 0; k < 2; ++k) dst[m][k] = *(const PG8_LAS bf16x8*)(lds + PG8_SA(b, h) + aoff + m * 2048 + k * 1024); } while (0)
#define PG8_LDB(dst, b, h) do { _Pragma("unroll") for (int n = 0; n < 2; ++n) _Pragma("unroll") for (int k = 0; k < 2; ++k) dst[n][k] = *(const PG8_LAS bf16x8*)(lds + PG8_SB(b, h) + boff + n * 2048 + k * 1024); } while (0)
#define PG8_MMA(ai, bj, At, Bt) do { __builtin_amdgcn_s_setprio(1); _Pragma("unroll") for (int m = 0; m < 4; ++m) _Pragma("unroll") for (int n = 0; n < 2; ++n) _Pragma("unroll") for (int k = 0; k < 2; ++k) \
        acc[ai][bj][m][n] = __builtin_amdgcn_mfma_f32_16x16x32_bf16(Bt[n][k], At[m][k], acc[ai][bj][m][n], 0, 0, 0); __builtin_amdgcn_s_setprio(0); } while (0)
#define PG8_WAIT_V(n) asm volatile("s_waitcnt vmcnt(" #n ")" ::: "memory")
#define PG8_WAIT_L(n) asm volatile("s_waitcnt lgkmcnt(" #n ")" ::: "memory")
#define PG8_BAR __builtin_amdgcn_s_barrier()
#define PG8_SCHED __builtin_amdgcn_sched_barrier(0)
    Unit cur, nxt; int ui = 0;
    if (!S.next(0, cur)) return;
    f32x4 acc[2][2][4][2];
#pragma unroll
    for (int a = 0; a < 2; ++a)
#pragma unroll
        for (int b = 0; b < 2; ++b)
#pragma unroll
            for (int m = 0; m < 4; ++m)
#pragma unroll
                for (int n = 0; n < 2; ++n) acc[a][b][m][n] = (f32x4){0.f, 0.f, 0.f, 0.f};
    bf16x8 At[4][2], B0[2][2], B1[2][2];
    const char* cA = (const char*)g.A + (size_t)cur.pm * tstep; const char* cB = (const char*)g.Bt + (size_t)cur.pn * tstep;
    S.a_ready(cur);
    if constexpr (SP2) {
        PG8_STAGE(PG8_SB(0, 0), cB, voffB); PG8_STAGE(PG8_SB(0, 1), cB + hstep, voffB); PG8_STAGE(PG8_SA(0, 0), cA, voffA); PG8_STAGE(PG8_SA(0, 1), cA + hstep, voffA);
        if (wr == 1) PG8_BAR;
        PG8_WAIT_V(2); PG8_BAR;
        PG8_STAGE(PG8_SB(1, 0), cB + kstep, voffB); PG8_STAGE(PG8_SA(1, 0), cA + kstep, voffA); PG8_STAGE(PG8_SB(1, 1), cB + hstep + kstep, voffB);
        PG8_WAIT_V(6); PG8_BAR;
    } else {
        PG8_STAGE(PG8_SB(0, 0), cB, voffB); PG8_STAGE(PG8_SA(0, 0), cA, voffA); PG8_STAGE(PG8_SB(0, 1), cB + hstep, voffB); PG8_STAGE(PG8_SA(0, 1), cA + hstep, voffA);
        if (wr == 1) PG8_BAR;
        PG8_WAIT_V(4); PG8_BAR;
        PG8_STAGE(PG8_SB(1, 0), cB + kstep, voffB); PG8_STAGE(PG8_SA(1, 0), cA + kstep, voffA); PG8_STAGE(PG8_SB(1, 1), cB + hstep + kstep, voffB);
        PG8_WAIT_V(6); PG8_BAR;
    }
    for (;;) {
        const bool has_next = S.next(ui + 1, nxt);
        const char* nA = has_next ? (const char*)g.A + (size_t)nxt.pm * tstep : cA; const char* nB = has_next ? (const char*)g.Bt + (size_t)nxt.pn * tstep : cB;
        for (int t = 0; t < nt; t += 2) {
            const bool last = (t == nt - 2);
            const char* a1 = cA + (size_t)(t + 1) * kstep;
            const char* a2 = last ? nA : cA + (size_t)(t + 2) * kstep; const char* b2 = last ? nB : cB + (size_t)(t + 2) * kstep;
            const char* a3 = a2 + kstep; const char* b3 = b2 + kstep;
            if (last && has_next) S.a_ready(nxt);
            if constexpr (SP2) {
            PG8_LDB(B0, 0, 0); PG8_LDB(B1, 0, 1); PG8_SCHED; PG8_LDA(At, 0, 0); PG8_STAGE(PG8_SA(1, 1), a1 + hstep, voffA);
            PG8_WAIT_V(8); PG8_WAIT_L(0); PG8_BAR; PG8_MMA(0, 0, At, B0); PG8_MMA(0, 1, At, B1); PG8_BAR; PG8_SCHED;
            PG8_LDA(At, 0, 1); PG8_STAGE(PG8_SB(0, 0), b2, voffB); PG8_STAGE(PG8_SB(0, 1), b2 + hstep, voffB); PG8_STAGE(PG8_SA(0, 0), a2, voffA);
            PG8_WAIT_V(8); PG8_WAIT_L(0); PG8_BAR; PG8_MMA(1, 0, At, B0); PG8_MMA(1, 1, At, B1); PG8_BAR; PG8_SCHED;
            PG8_LDB(B0, 1, 0); PG8_LDB(B1, 1, 1); PG8_SCHED; PG8_LDA(At, 1, 0); PG8_STAGE(PG8_SA(0, 1), a2 + hstep, voffA);
            PG8_WAIT_V(8); PG8_WAIT_L(0); PG8_BAR; PG8_MMA(0, 0, At, B0); PG8_MMA(0, 1, At, B1); PG8_BAR; PG8_SCHED;
            PG8_LDA(At, 1, 1); PG8_STAGE(PG8_SB(1, 0), b3, voffB); PG8_STAGE(PG8_SB(1, 1), b3 + hstep, voffB); PG8_STAGE(PG8_SA(1, 0), a3, voffA);
            PG8_WAIT_V(8); PG8_WAIT_L(0); PG8_BAR; PG8_MMA(1, 0, At, B0); PG8_MMA(1, 1, At, B1); PG8_BAR; PG8_SCHED;
            } else {
            PG8_LDB(B0, 0, 0); PG8_SCHED; PG8_LDA(At, 0, 0); PG8_STAGE(PG8_SA(1, 1), a1 + hstep, voffA);
            PG8_WAIT_L(8); PG8_BAR; PG8_WAIT_L(0); PG8_MMA(0, 0, At, B0); PG8_BAR; PG8_SCHED;
            PG8_LDB(B1, 0, 1); PG8_STAGE(PG8_SB(0, 0), b2, voffB);
            PG8_BAR; PG8_WAIT_L(0); PG8_MMA(0, 1, At, B1); PG8_BAR;
            PG8_LDA(At, 0, 1); PG8_STAGE(PG8_SA(0, 0), a2, voffA);
            PG8_BAR; PG8_WAIT_L(0); PG8_MMA(1, 0, At, B0); PG8_BAR; PG8_SCHED;
            PG8_STAGE(PG8_SB(0, 1), b2 + hstep, voffB);
            PG8_WAIT_V(6); PG8_BAR; PG8_MMA(1, 1, At, B1); PG8_BAR;
            PG8_LDB(B0, 1, 0); PG8_SCHED; PG8_LDA(At, 1, 0); PG8_STAGE(PG8_SA(0, 1), a2 + hstep, voffA);
            PG8_WAIT_L(8); PG8_BAR; PG8_WAIT_L(0); PG8_MMA(0, 0, At, B0); PG8_BAR; PG8_SCHED;
            PG8_LDB(B1, 1, 1); PG8_STAGE(PG8_SB(1, 0), b3, voffB);
            PG8_BAR; PG8_WAIT_L(0); PG8_MMA(0, 1, At, B1); PG8_BAR;
            PG8_LDA(At, 1, 1); PG8_STAGE(PG8_SA(1, 0), a3, voffA);
            PG8_BAR; PG8_WAIT_L(0); PG8_MMA(1, 0, At, B0); PG8_BAR; PG8_SCHED;
            PG8_STAGE(PG8_SB(1, 1), b3 + hstep, voffB);
            PG8_WAIT_V(6); PG8_BAR; PG8_MMA(1, 1, At, B1); PG8_BAR;
            }
        }
        if constexpr (ALIGN_EPI) { if (wr == 0) PG8_BAR; }
        if constexpr (!Epi::AFTER_DRAIN) { E(acc, cur, wr, wc, fr, fq); S.done(cur); }
        if (!has_next) break;
#pragma unroll
        for (int a = 0; a < 2; ++a)
#pragma unroll
            for (int b = 0; b < 2; ++b)
#pragma unroll
                for (int m = 0; m < 4; ++m)
#pragma unroll
                    for (int n = 0; n < 2; ++n) acc[a][b][m][n] = (f32x4){0.f, 0.f, 0.f, 0.f};
        cur = nxt; cA = nA; cB = nB; ++ui;
        if constexpr (ALIGN_EPI) { if (wr == 1) PG8_BAR; }
    }
    PG8_WAIT_V(0);
    if constexpr (!ALIGN_EPI) { if (wr == 0) PG8_BAR; }
    PG8_BAR;
    if constexpr (Epi::AFTER_DRAIN) { E.fused(acc, cur, wr, wc, fr, fq, lds, wid, lane); S.done(cur); }
#undef PG8_SA
#undef PG8_SB
#undef PG8_STAGE
#undef PG8_LDA
#undef PG8_LDB
#undef PG8_MMA
#undef PG8_WAIT_V
#undef PG8_WAIT_L
#undef PG8_BAR
#undef PG8_SCHED
}
}

#define LAS __attribute__((address_space(3)))
using pg8::bf16_t; using pg8::bf16x8; using pg8::f32x4; using pg8::u32x4;
typedef unsigned u32x2 __attribute__((ext_vector_type(2)));

constexpr int BATCH = 4, SEQ = 8192, DM = 2048, DFF = 5632, M = BATCH * SEQ, NCH = SEQ / 64, DEPTH = 4;
constexpr int EV_N = 5136, EV_NP = 5376, OD_N = 3072;
constexpr float EPS = 1e-6f;
constexpr int NTHREADS = 512, NWAVES = 8, LDS_BYTES = 147456;

constexpr size_t MiB = (size_t)1 << 20;
constexpr size_t WS_CTL = 0;
constexpr size_t WS_W1A = 1 * MiB;
constexpr size_t WS_W1B = 45 * MiB;
constexpr size_t WS_W2A = 89 * MiB;
constexpr size_t WS_W2B = 111 * MiB;
constexpr size_t WS_WIN = 133 * MiB;
constexpr size_t WS_WOUT = 154 * MiB;
constexpr size_t WS_WAT = 162 * MiB;
constexpr size_t WS_WXT = WS_WAT + 262144;
constexpr size_t WS_POOLT = WS_WAT + 524288;
constexpr size_t WS_U = 163 * MiB;
constexpr size_t WS_HB = 291 * MiB;
constexpr size_t WS_HO = 643 * MiB;
constexpr size_t WS_T = 771 * MiB;
constexpr size_t WS_S = 1027 * MiB;
constexpr size_t WS_END = 1043 * MiB;
constexpr size_t WS_HLOC = WS_T, WS_APROD = WS_T + 64 * MiB, WS_QDEC = WS_T + 128 * MiB, WS_KDECT = WS_T + 160 * MiB, WS_VTG = WS_T + 192 * MiB;
constexpr size_t WS_XC = WS_T, WS_Q = WS_T + 64 * MiB, WS_KT = WS_T + 128 * MiB, WS_WVT = WS_T + 192 * MiB;
constexpr size_t WS_V = WS_HB + 192 * MiB, WS_KB = WS_HB + 256 * MiB;
constexpr size_t WS_CARA = WS_S, WS_CARH = WS_S + 2 * MiB, WS_DEC = WS_S + 4 * MiB, WS_GATES = WS_S + 5 * MiB, WS_TOK = WS_S + 6 * MiB, WS_SC = WS_S + 8 * MiB, WS_NU = WS_S + 9 * MiB;

enum { I_X = 0, I_NORMG, I_WG, I_WU, I_WD, I_EVIN, I_EVOUT, I_LCW, I_LCB, I_LWA, I_LBA, I_LWX, I_LBX, I_LLAM, I_GWG, I_GBG, I_GNORM,
       I_ODIN, I_ODOUT, I_MCW, I_MCB, I_MWQ, I_MWK, I_MWV, I_MWIF, I_MBIF, I_MSKIP, I_MNORM, I_POOLW, I_POOLS };

struct KP { const float* in[30]; float* out; unsigned char* ws; };
#define GP(T, off) ((T*)(p.ws + (off)))

__device__ __forceinline__ float bf2f(bf16_t b) { return __uint_as_float(((unsigned)b) << 16); }
__device__ __forceinline__ float bflo(unsigned w) { return __uint_as_float(w << 16); }
__device__ __forceinline__ float bfhi(unsigned w) { return __uint_as_float(w & 0xffff0000u); }
__device__ __forceinline__ bf16_t f2bf(float f) { unsigned u = __float_as_uint(f); u += 0x7fffu + ((u >> 16) & 1u); return (bf16_t)(u >> 16); }
__device__ __forceinline__ unsigned pk2(float lo, float hi) { return (unsigned)f2bf(lo) | ((unsigned)f2bf(hi) << 16); }
__device__ __forceinline__ float wave_sum(float v) {
#pragma unroll
    for (int o = 1; o < 64; o <<= 1) v += __shfl_xor(v, o);
    return v;
}
__device__ __forceinline__ float wave_max(float v) {
#pragma unroll
    for (int o = 1; o < 64; o <<= 1) v = fmaxf(v, __shfl_xor(v, o));
    return v;
}
__device__ __forceinline__ float sigmoid_f(float x) { return 1.0f / (1.0f + __expf(-x)); }
__device__ __forceinline__ float logsigmoid_f(float x) { return fminf(x, 0.0f) - log1pf(__expf(-fabsf(x))); }
__device__ __forceinline__ float gelu_tanh_f(float x) { const float y = 0.7978845608028654f * (x + 0.044715f * x * x * x); const float t = 1.0f - 2.0f / (__expf(2.0f * y) + 1.0f); return 0.5f * x * (1.0f + t); }
#define MFMA16(a, b, c) __builtin_amdgcn_mfma_f32_16x16x32_bf16((a), (b), (c), 0, 0, 0)
__device__ __forceinline__ bf16x8 lds_frag(const LAS bf16_t* base, int ld, int r0, int k0, int lane) { return *(const LAS bf16x8*)(base + (r0 + (lane & 15)) * ld + k0 + (lane >> 4) * 8); }
__device__ __forceinline__ bf16x8 glb_frag(const bf16_t* base, int ld, int r0, int k0, int lane) { return *(const bf16x8*)(base + (size_t)(r0 + (lane & 15)) * ld + k0 + (lane >> 4) * 8); }
#define F4ZERO ((f32x4){0.f, 0.f, 0.f, 0.f})

__device__ __forceinline__ void tr_item(const float* W, int K, int N, bf16_t* WT, int k0, int n0, int drow0, LAS float* scr, int lane) {
#pragma unroll 8
    for (int i = 0; i < 32; ++i) { const int kk = 2 * i + (lane >> 5), n = n0 + (lane & 31); scr[kk * 33 + (lane & 31)] = (n < N) ? W[(size_t)(k0 + kk) * N + n] : 0.f; }
    asm volatile("s_waitcnt lgkmcnt(0)" ::: "memory");
    const int c = lane & 7;
#pragma unroll
    for (int jj = 0; jj < 4; ++jj) { const int n = (lane >> 3) + 8 * jj; const LAS float* s = scr + (8 * c) * 33 + n;
        u32x4 o; o.x = pk2(s[0 * 33], s[1 * 33]); o.y = pk2(s[2 * 33], s[3 * 33]); o.z = pk2(s[4 * 33], s[5 * 33]); o.w = pk2(s[6 * 33], s[7 * 33]);
        if (n0 + n < N) *(u32x4*)(WT + (size_t)(drow0 + n) * K + k0 + 8 * c) = o; }
    asm volatile("s_waitcnt lgkmcnt(0)" ::: "memory");
}
__device__ __forceinline__ void ph_weights(const KP& p, int l, LAS unsigned char* lds) {
    const int tid = threadIdx.x, lane = tid & 63, wave = tid >> 6;
    LAS float* scr = (LAS float*)(lds + wave * 8704);
    const int gw = blockIdx.x * NWAVES + wave, NGW = gridDim.x * NWAVES, j = l >> 1;
    const bool even = (l & 1) == 0;
    constexpr int FI = (DM / 64) * (DFF / 32);
    const int n_in = even ? (DM / 64) * ((EV_N + 31) / 32) : (DM / 64) * (OD_N / 32), n_out = (DM / 64) * (DM / 32);
    const int n_small = 128;
    const int total = 6 * FI + n_in + n_out + n_small;
    for (int it = gw; it < total; it += NGW) {
        const float* W; bf16_t* WT; int K, N, mode = 0, r;
        if (it < 6 * FI) { const int mtx = it / FI; r = it % FI; const int s = mtx / 3, kind = mtx % 3; const size_t wo = (size_t)(l * 2 + s) * DM * DFF;
            if (kind == 0) { W = p.in[I_WG] + wo; K = DM; N = DFF; WT = GP(bf16_t, s ? WS_W1B : WS_W1A); mode = 1; }
            else if (kind == 1) { W = p.in[I_WU] + wo; K = DM; N = DFF; WT = GP(bf16_t, s ? WS_W1B : WS_W1A); mode = 2; }
            else { W = p.in[I_WD] + wo; K = DFF; N = DM; WT = GP(bf16_t, s ? WS_W2B : WS_W2A); } }
        else { r = it - 6 * FI;
            if (r < n_in) { K = DM; WT = GP(bf16_t, WS_WIN); if (even) { W = p.in[I_EVIN] + (size_t)j * DM * EV_N; N = EV_N; } else { W = p.in[I_ODIN] + (size_t)j * DM * OD_N; N = OD_N; } }
            else if (r < n_in + n_out) { r -= n_in; K = DM; N = DM; WT = GP(bf16_t, WS_WOUT); W = (even ? p.in[I_EVOUT] : p.in[I_ODOUT]) + (size_t)j * DM * DM; }
            else { r -= n_in + n_out;
                if (even) { const int mi = r >> 3; r &= 7; K = 128; N = 128; const int hd = mi & 7; W = (mi < 8 ? p.in[I_LWA] : p.in[I_LWX]) + (size_t)(j * 8 + hd) * 16384; WT = GP(bf16_t, mi < 8 ? WS_WAT : WS_WXT) + hd * 16384; }
                else { const int g = r >> 5; r &= 31; K = 256; N = 256; W = p.in[I_POOLW] + (size_t)(j * 4 + g) * 65536; WT = GP(bf16_t, WS_POOLT) + g * 65536; } } }
        const int nb = (N + 31) >> 5, kb = r / nb, nbi = r % nb, n0 = nbi * 32;
        const int drow0 = mode == 0 ? n0 : ((n0 >> 7) * 256 + (n0 & 127) + (mode == 2 ? 128 : 0));
        tr_item(W, K, N, WT, kb * 64, n0, drow0, scr, lane);
    }
    if (even) {
        u32x4* z = (u32x4*)(GP(bf16_t, WS_WIN) + (size_t)EV_N * DM); const int n16 = (EV_NP - EV_N) * DM * 2 / 16;
        for (int i = blockIdx.x * NTHREADS + tid; i < n16; i += gridDim.x * NTHREADS) z[i] = (u32x4){0u, 0u, 0u, 0u};
    }
}

__device__ __forceinline__ void ph_norm(const float* xin, float* xout, const bf16_t* h, float scale, const float* ga, const float* gb, bf16_t* u) {
    const int tid = threadIdx.x, lane = tid & 63, wave = tid >> 6;
    const int gw = blockIdx.x * NWAVES + wave, NGW = gridDim.x * NWAVES;
    for (int row = gw; row < M; row += NGW) {
        f32x4 xv[8];
        const f32x4* xr = (const f32x4*)(xin + (size_t)row * DM) + lane;
#pragma unroll
        for (int jx = 0; jx < 8; ++jx) xv[jx] = xr[64 * jx];
        if (h) {
            const u32x2* hr = (const u32x2*)(h + (size_t)row * DM) + lane; f32x4 hv[8]; float ss = 0.f;
#pragma unroll
            for (int jx = 0; jx < 8; ++jx) { const u32x2 w = hr[64 * jx]; hv[jx] = (f32x4){bflo(w.x), bfhi(w.x), bflo(w.y), bfhi(w.y)}; ss += (hv[jx][0] * hv[jx][0] + hv[jx][1] * hv[jx][1]) + (hv[jx][2] * hv[jx][2] + hv[jx][3] * hv[jx][3]); }
            ss = wave_sum(ss); const float rs = rsqrtf(ss * (1.0f / DM) + EPS) * scale;
#pragma unroll
            for (int jx = 0; jx < 8; ++jx) { const f32x4 g = ((const f32x4*)ga)[64 * jx + lane]; xv[jx] = xv[jx] + hv[jx] * g * rs; }
        }
        if (xout) { f32x4* xo = (f32x4*)(xout + (size_t)row * DM) + lane;
#pragma unroll
            for (int jx = 0; jx < 8; ++jx) xo[64 * jx] = xv[jx]; }
        if (u) {
            float ss = 0.f;
#pragma unroll
            for (int jx = 0; jx < 8; ++jx) ss += (xv[jx][0] * xv[jx][0] + xv[jx][1] * xv[jx][1]) + (xv[jx][2] * xv[jx][2] + xv[jx][3] * xv[jx][3]);
            ss = wave_sum(ss); const float rs = rsqrtf(ss * (1.0f / DM) + EPS);
            u32x2* ur = (u32x2*)(u + (size_t)row * DM) + lane;
#pragma unroll
            for (int jx = 0; jx < 8; ++jx) { const f32x4 g = ((const f32x4*)gb)[64 * jx + lane]; const f32x4 o = xv[jx] * g * rs; u32x2 w; w.x = pk2(o[0], o[1]); w.y = pk2(o[2], o[3]); ur[64 * jx] = w; }
        }
    }
}

__device__ __forceinline__ void lru_local_unit(const KP& p, int j, int b, int n, int hd, LAS unsigned char* lds) {
    const int tid = threadIdx.x, lane = tid & 63, wave = tid >> 6;
    LAS bf16_t* A = (LAS bf16_t*)lds; LAS float* LA = (LAS float*)(lds + 17408); LAS float* BI = (LAS float*)(lds + 51200); LAS float* SEG = (LAS float*)(lds + 84992);
    const bf16_t* Z = GP(const bf16_t, WS_HB);
    const int row0 = b * SEQ + n * 64, c0 = hd * 128;
    { const int c = tid & 127, q = tid >> 7, t0 = q * 16, cc = c0 + c, pos0 = n * 64 + t0;
      const float* cw = p.in[I_LCW] + (size_t)j * 4096; const float w0 = cw[cc], w1 = cw[1024 + cc], w2 = cw[2048 + cc], w3 = cw[3072 + cc], cb = p.in[I_LCB][j * 1024 + cc];
      const bf16_t* zp = Z + (size_t)row0 * EV_NP + cc;
      float x3 = 0.f, x2 = 0.f, x1 = 0.f;
      if (pos0 >= 3) x3 = bf2f(zp[(ptrdiff_t)(t0 - 3) * EV_NP]);
      if (pos0 >= 2) x2 = bf2f(zp[(ptrdiff_t)(t0 - 2) * EV_NP]);
      if (pos0 >= 1) x1 = bf2f(zp[(ptrdiff_t)(t0 - 1) * EV_NP]);
#pragma unroll
      for (int i = 0; i < 16; ++i) { const int t = t0 + i; const float xv = bf2f(zp[(size_t)t * EV_NP]); const float xc = w0 * x3 + w1 * x2 + w2 * x1 + w3 * xv + cb; A[t * 136 + c] = f2bf(xc); x3 = x2; x2 = x1; x1 = xv; } }
    __syncthreads();
    { const bf16_t* waT = GP(const bf16_t, WS_WAT) + (size_t)hd * 16384; const bf16_t* wxT = GP(const bf16_t, WS_WXT) + (size_t)hd * 16384;
      f32x4 aa[4], ax[4];
#pragma unroll
      for (int tt = 0; tt < 4; ++tt) { aa[tt] = F4ZERO; ax[tt] = F4ZERO; }
#pragma unroll
      for (int ks = 0; ks < 4; ++ks) { const bf16x8 fa = glb_frag(waT, 128, wave * 16, ks * 32, lane), fx = glb_frag(wxT, 128, wave * 16, ks * 32, lane);
#pragma unroll
          for (int tt = 0; tt < 4; ++tt) { const bf16x8 af = lds_frag(A, 136, tt * 16, ks * 32, lane); aa[tt] = MFMA16(af, fa, aa[tt]); ax[tt] = MFMA16(af, fx, ax[tt]); } }
      const int jj = wave * 16 + (lane & 15), cj = c0 + jj;
      const float ba = p.in[I_LBA][j * 1024 + cj], bx = p.in[I_LBX][j * 1024 + cj], lam = p.in[I_LLAM][j * 1024 + cj];
      const float sp = log1pf(__expf(-lam));
#pragma unroll
      for (int tt = 0; tt < 4; ++tt)
#pragma unroll
          for (int i = 0; i < 4; ++i) { const int t = tt * 16 + (lane >> 4) * 4 + i; const float r = sigmoid_f(aa[tt][i] + ba), ig = sigmoid_f(ax[tt][i] + bx);
              const float la = -8.0f * r * sp, xcv = bf2f(A[t * 136 + jj]); LA[t * 132 + jj] = la; BI[t * 132 + jj] = sqrtf(-expm1f(2.0f * la)) * ig * xcv; } }
    __syncthreads();
    { const int c = tid & 127, q = tid >> 7, t0 = q * 16; float cs = 0.f, h = 0.f; float hs[16], cc_[16];
#pragma unroll
      for (int i = 0; i < 16; ++i) { const float la = LA[(t0 + i) * 132 + c]; cs += la; h = __expf(la) * h + BI[(t0 + i) * 132 + c]; hs[i] = h; cc_[i] = cs; }
      SEG[(q * 128 + c) * 2] = cs; SEG[(q * 128 + c) * 2 + 1] = h;
      __syncthreads();
      float Hs = 0.f, Cs = 0.f;
      for (int q2 = 0; q2 < q; ++q2) { const float a = SEG[(q2 * 128 + c) * 2], hh = SEG[(q2 * 128 + c) * 2 + 1]; Hs = __expf(a) * Hs + hh; Cs += a; }
      bf16_t* hl = GP(bf16_t, WS_HLOC) + (size_t)row0 * 1024 + c0 + c; bf16_t* ap = GP(bf16_t, WS_APROD) + (size_t)row0 * 1024 + c0 + c;
#pragma unroll
      for (int i = 0; i < 16; ++i) { const int t = t0 + i; hl[(size_t)t * 1024] = f2bf(hs[i] + __expf(cc_[i]) * Hs); ap[(size_t)t * 1024] = f2bf(__expf(cc_[i] + Cs)); }
      if (q == 3) { const size_t ci = (size_t)(b * NCH + n) * 1024 + c0 + c; GP(float, WS_CARA)[ci] = __expf(cc_[15] + Cs); GP(float, WS_CARH)[ci] = hs[15] + __expf(cc_[15]) * Hs; } }
    __syncthreads();
}

__device__ __forceinline__ void gla_prep_unit(const KP& p, int j, int b, int n, int h, LAS unsigned char* lds) {
    const int tid = threadIdx.x, lane = tid & 63, wave = tid >> 6;
    LAS bf16_t* Qd = (LAS bf16_t*)lds; LAS bf16_t* Ki = (LAS bf16_t*)(lds + 17408); LAS bf16_t* Vt = (LAS bf16_t*)(lds + 34816); LAS bf16_t* Ps = (LAS bf16_t*)(lds + 71680);
    LAS float* SEG = (LAS float*)(lds + 80896); LAS float* GLR = (LAS float*)(lds + 82944);
    const bf16_t* Z = GP(const bf16_t, WS_HB);
    const int row0 = b * SEQ + n * 64, ug = (b * NCH + n) * 4 + h;
    { const int t = tid >> 3, r = (tid & 7) * 2; const unsigned w = *(const unsigned*)(Z + (size_t)(row0 + t) * EV_NP + 5120 + r); GLR[t * 16 + r] = bflo(w); GLR[t * 16 + r + 1] = bfhi(w); }
    { const int jv = tid & 255, th = tid >> 8; const bf16_t* vp = Z + (size_t)row0 * EV_NP + 3072 + h * 256 + jv;
#pragma unroll 8
      for (int i = 0; i < 32; ++i) { const int t = th * 32 + i; Vt[jv * 72 + t] = vp[(size_t)t * EV_NP]; } }
    __syncthreads();
    { const int d = tid & 127, q = tid >> 7;
      float gu[16];
#pragma unroll
      for (int r = 0; r < 16; ++r) gu[r] = p.in[I_GWG][(size_t)(j * 16 + r) * 512 + h * 128 + d];
      const float gb = p.in[I_GBG][j * 512 + h * 128 + d];
      float lc[16]; float cs = 0.f;
#pragma unroll
      for (int i = 0; i < 16; ++i) { const int t = q * 16 + i; float pre = gb;
#pragma unroll
          for (int r = 0; r < 16; ++r) pre += GLR[t * 16 + r] * gu[r];
          cs += logsigmoid_f(pre) * 0.0625f; lc[i] = cs; }
      SEG[q * 128 + d] = cs;
      __syncthreads();
      float pref = 0.f, blast = 0.f;
#pragma unroll
      for (int q2 = 0; q2 < 4; ++q2) { const float s = SEG[q2 * 128 + d]; if (q2 < q) pref += s; blast += s; }
      const bf16_t* qp = Z + (size_t)row0 * EV_NP + 2048 + h * 128 + d; const bf16_t* kp = Z + (size_t)row0 * EV_NP + 2560 + h * 128 + d;
      bf16_t* qdg = GP(bf16_t, WS_QDEC) + (size_t)ug * 8192;
      unsigned kd[8];
#pragma unroll
      for (int i = 0; i < 16; ++i) { const int t = q * 16 + i; const float bc = pref + lc[i]; const float qv = bf2f(qp[(size_t)t * EV_NP]), kv = bf2f(kp[(size_t)t * EV_NP]);
          const bf16_t qd = f2bf(qv * 0.08838834764831845f * __expf(bc)); Qd[t * 136 + d] = qd; qdg[t * 128 + d] = qd;
          Ki[t * 136 + d] = f2bf(kv * __expf(-bc));
          const unsigned kdv = f2bf(kv * __expf(blast - bc)); if (i & 1) kd[i >> 1] |= kdv << 16; else kd[i >> 1] = kdv; }
      u32x4* kdst = (u32x4*)(GP(bf16_t, WS_KDECT) + (size_t)ug * 8192 + d * 64 + q * 16);
      kdst[0] = (u32x4){kd[0], kd[1], kd[2], kd[3]}; kdst[1] = (u32x4){kd[4], kd[5], kd[6], kd[7]};
      if (q == 0) GP(float, WS_DEC)[(size_t)ug * 128 + d] = __expf(blast); }
    __syncthreads();
    { const int tt = wave >> 1, stb = (wave & 1) * 2; f32x4 acc[2] = {F4ZERO, F4ZERO};
#pragma unroll
      for (int ks = 0; ks < 4; ++ks) { const bf16x8 a = lds_frag(Qd, 136, tt * 16, ks * 32, lane);
#pragma unroll
          for (int s2 = 0; s2 < 2; ++s2) { const bf16x8 bfr = lds_frag(Ki, 136, (stb + s2) * 16, ks * 32, lane); acc[s2] = MFMA16(a, bfr, acc[s2]); } }
#pragma unroll
      for (int s2 = 0; s2 < 2; ++s2)
#pragma unroll
          for (int i = 0; i < 4; ++i) { const int t = tt * 16 + (lane >> 4) * 4 + i, s = (stb + s2) * 16 + (lane & 15); Ps[t * 72 + s] = (s <= t) ? f2bf(acc[s2][i]) : (bf16_t)0; } }
    __syncthreads();
    { f32x4 acc[2][4];
#pragma unroll
      for (int jt = 0; jt < 2; ++jt)
#pragma unroll
          for (int tt = 0; tt < 4; ++tt) acc[jt][tt] = F4ZERO;
#pragma unroll
      for (int jt = 0; jt < 2; ++jt)
#pragma unroll
          for (int ks = 0; ks < 2; ++ks) { const bf16x8 a = lds_frag(Vt, 72, (2 * wave + jt) * 16, ks * 32, lane);
#pragma unroll
              for (int tt = 0; tt < 4; ++tt) { const bf16x8 bfr = lds_frag(Ps, 72, tt * 16, ks * 32, lane); acc[jt][tt] = MFMA16(a, bfr, acc[jt][tt]); } }
      float* OI = GP(float, WS_HO);
#pragma unroll
      for (int jt = 0; jt < 2; ++jt)
#pragma unroll
          for (int tt = 0; tt < 4; ++tt) { const int jj = (2 * wave + jt) * 16 + (lane >> 4) * 4, t = tt * 16 + (lane & 15); *(f32x4*)(OI + (size_t)(row0 + t) * 1024 + h * 256 + jj) = acc[jt][tt]; } }
    { const int jv = tid >> 1, half = tid & 1; const LAS u32x4* src = (const LAS u32x4*)(Vt + jv * 72 + half * 32); u32x4* dst = (u32x4*)(GP(bf16_t, WS_VTG) + (size_t)ug * 16384 + jv * 64 + half * 32);
#pragma unroll
      for (int k = 0; k < 4; ++k) dst[k] = src[k]; }
    __syncthreads();
}

__device__ __forceinline__ void gla_scan_unit(const KP& p, int b, int h, int vs, LAS unsigned char* lds) {
    const int tid = threadIdx.x, lane = tid & 63, wave = tid >> 6;
    LAS bf16_t* Qs = (LAS bf16_t*)lds; LAS bf16_t* KT = (LAS bf16_t*)(lds + 17408); LAS bf16_t* VTs = (LAS bf16_t*)(lds + 35840); LAS bf16_t* Ss = (LAS bf16_t*)(lds + 40448); LAS float* dec = (LAS float*)(lds + 49152);
    const bf16_t* QDEC = GP(const bf16_t, WS_QDEC); const bf16_t* KDECT = GP(const bf16_t, WS_KDECT); const bf16_t* VTG = GP(const bf16_t, WS_VTG); const float* DEC = GP(const float, WS_DEC);
    float* OI = GP(float, WS_HO);
    f32x4 Sacc[2] = {F4ZERO, F4ZERO};
    for (int i = tid; i < 32 * 136 / 2; i += NTHREADS) ((LAS unsigned*)Ss)[i] = 0u;
    u32x4 rq[2], rk[2], rv = (u32x4){0u, 0u, 0u, 0u}; float rdec = 0.f;
#define GLA_LOAD(nn) do { const size_t ug_ = (size_t)((b * NCH + (nn)) * 4 + h); \
        { const u32x4* s_ = (const u32x4*)(QDEC + ug_ * 8192 + (tid >> 3) * 128 + (tid & 7) * 16); rq[0] = s_[0]; rq[1] = s_[1]; } \
        { const u32x4* s_ = (const u32x4*)(KDECT + ug_ * 8192 + (tid >> 2) * 64 + (tid & 3) * 16); rk[0] = s_[0]; rk[1] = s_[1]; } \
        if (tid < 256) rv = *(const u32x4*)(VTG + ug_ * 16384 + (size_t)(vs * 32 + (tid >> 3)) * 64 + (tid & 7) * 8); \
        if (tid < 128) rdec = DEC[ug_ * 128 + tid]; } while (0)
    GLA_LOAD(0);
    for (int n = 0; n < NCH; ++n) {
        const int row0 = b * SEQ + n * 64;
        { LAS u32x4* d_ = (LAS u32x4*)(Qs + (tid >> 3) * 136 + (tid & 7) * 16); d_[0] = rq[0]; d_[1] = rq[1]; }
        { LAS u32x4* d_ = (LAS u32x4*)(KT + (tid >> 2) * 72 + (tid & 3) * 16); d_[0] = rk[0]; d_[1] = rk[1]; }
        if (tid < 256) *(LAS u32x4*)(VTs + (tid >> 3) * 72 + (tid & 7) * 8) = rv;
        if (tid < 128) dec[tid] = rdec;
        __syncthreads();
        if (n + 1 < NCH) GLA_LOAD(n + 1);
        { const int jt = wave >> 2, tt = wave & 3; f32x4 acc = F4ZERO;
#pragma unroll
          for (int ks = 0; ks < 4; ++ks) { const bf16x8 a = lds_frag(Ss, 136, jt * 16, ks * 32, lane), bfr = lds_frag(Qs, 136, tt * 16, ks * 32, lane); acc = MFMA16(a, bfr, acc); }
          const int t = tt * 16 + (lane & 15), jj = vs * 32 + jt * 16 + (lane >> 4) * 4; f32x4* op = (f32x4*)(OI + (size_t)(row0 + t) * 1024 + h * 256 + jj); *op = *op + acc; }
        { f32x4 tmp[2] = {F4ZERO, F4ZERO};
#pragma unroll
          for (int ks = 0; ks < 2; ++ks) { const bf16x8 a = lds_frag(KT, 72, wave * 16, ks * 32, lane);
#pragma unroll
              for (int jt = 0; jt < 2; ++jt) { const bf16x8 bfr = lds_frag(VTs, 72, jt * 16, ks * 32, lane); tmp[jt] = MFMA16(a, bfr, tmp[jt]); } }
          const f32x4 dv = *(const LAS f32x4*)(dec + wave * 16 + (lane >> 4) * 4);
#pragma unroll
          for (int jt = 0; jt < 2; ++jt) Sacc[jt] = Sacc[jt] * dv + tmp[jt]; }
        __syncthreads();
#pragma unroll
        for (int jt = 0; jt < 2; ++jt) { const int jcol = jt * 16 + (lane & 15), d0 = wave * 16 + (lane >> 4) * 4; u32x2 w; w.x = pk2(Sacc[jt][0], Sacc[jt][1]); w.y = pk2(Sacc[jt][2], Sacc[jt][3]); *(LAS u32x2*)(Ss + jcol * 136 + d0) = w; }
    }
#undef GLA_LOAD
    __syncthreads();
}

__device__ __forceinline__ void lru_fix_unit(const KP& p, int b, int n) {
    const int tid = threadIdx.x; const int c = 2 * tid;
    const float* CA = GP(const float, WS_CARA) + (size_t)b * NCH * 1024 + c; const float* CH = GP(const float, WS_CARH) + (size_t)b * NCH * 1024 + c;
    float H0 = 0.f, H1 = 0.f;
#pragma unroll 8
    for (int n2 = 0; n2 < n; ++n2) { const float2 a = *(const float2*)(CA + (size_t)n2 * 1024), hh = *(const float2*)(CH + (size_t)n2 * 1024); H0 = a.x * H0 + hh.x; H1 = a.y * H1 + hh.y; }
    const int row0 = b * SEQ + n * 64;
    const bf16_t* hl = GP(const bf16_t, WS_HLOC) + (size_t)row0 * 1024 + c; const bf16_t* ap = GP(const bf16_t, WS_APROD) + (size_t)row0 * 1024 + c;
    const bf16_t* yb = GP(const bf16_t, WS_HB) + (size_t)row0 * EV_NP + 1024 + c; bf16_t* mix = GP(bf16_t, WS_U) + (size_t)row0 * DM + c;
#pragma unroll 4
    for (int t = 0; t < 64; ++t) { const unsigned wh = *(const unsigned*)(hl + (size_t)t * 1024), wa = *(const unsigned*)(ap + (size_t)t * 1024), wy = *(const unsigned*)(yb + (size_t)t * EV_NP);
        const float h0 = bflo(wh) + bflo(wa) * H0, h1 = bfhi(wh) + bfhi(wa) * H1;
        *(unsigned*)(mix + (size_t)t * DM) = pk2(h0 * gelu_tanh_f(bflo(wy)), h1 * gelu_tanh_f(bfhi(wy))); }
}

__device__ __forceinline__ void ph_gla_final(const KP& p, int j) {
    const int tid = threadIdx.x, lane = tid & 63, wave = tid >> 6;
    const int gw = blockIdx.x * NWAVES + wave, NGW = gridDim.x * NWAVES;
    const float* OI = GP(const float, WS_HO); const bf16_t* Z = GP(const bf16_t, WS_HB); bf16_t* MIX = GP(bf16_t, WS_U);
    for (int row = gw; row < M; row += NGW) {
#pragma unroll
        for (int h = 0; h < 4; ++h) { const int c = h * 256 + lane * 4; const f32x4 o = *(const f32x4*)(OI + (size_t)row * 1024 + c);
            const float ss = wave_sum((o[0] * o[0] + o[1] * o[1]) + (o[2] * o[2] + o[3] * o[3])); const float rs = rsqrtf(ss * (1.0f / 256.0f) + EPS);
            const f32x4 gn = *(const f32x4*)(p.in[I_GNORM] + j * 1024 + c); const u32x2 rw = *(const u32x2*)(Z + (size_t)row * EV_NP + 4096 + c);
            const float r0 = bflo(rw.x), r1 = bfhi(rw.x), r2 = bflo(rw.y), r3 = bfhi(rw.y);
            u32x2 w; w.x = pk2(o[0] * rs * gn[0] * pg8::silu_f(r0), o[1] * rs * gn[1] * pg8::silu_f(r1)); w.y = pk2(o[2] * rs * gn[2] * pg8::silu_f(r2), o[3] * rs * gn[3] * pg8::silu_f(r3));
            *(u32x2*)(MIX + (size_t)row * DM + 1024 + c) = w; }
    }
}

__device__ __forceinline__ void mlstm_tok_unit(const KP& p, int j, int b, int n, LAS unsigned char* lds) {
    const int tid = threadIdx.x, lane = tid & 63, wave = tid >> 6;
    LAS float* RED = (LAS float*)lds;
    const bf16_t* Z = GP(const bf16_t, WS_HB);
    const int g = tid & 255, th = tid >> 8, c = 4 * g, row0 = b * SEQ + n * 64, t0 = th * 32, pos0 = n * 64 + t0;
    LAS float* EQ = (LAS float*)(lds + 8192); LAS float* EV = (LAS float*)(lds + 8192 + 32768);
    float cw[4][4], cb[4], wq[4][4], wk[4][4], wv[4][4];
#pragma unroll
    for (int k = 0; k < 4; ++k)
#pragma unroll
        for (int i = 0; i < 4; ++i) cw[k][i] = p.in[I_MCW][(size_t)(j * 4 + k) * 1024 + c + i];
#pragma unroll
    for (int i = 0; i < 4; ++i) cb[i] = p.in[I_MCB][j * 1024 + c + i];
#pragma unroll
    for (int i = 0; i < 4; ++i)
#pragma unroll
        for (int jj = 0; jj < 4; ++jj) { const size_t wi = ((size_t)(j * 256 + g) * 4 + i) * 4 + jj; wq[i][jj] = p.in[I_MWQ][wi]; wk[i][jj] = p.in[I_MWK][wi]; wv[i][jj] = p.in[I_MWV][wi]; }
    { const float* wif = p.in[I_MWIF] + (size_t)j * 3072 * 8;
#pragma unroll
      for (int i = 0; i < 4; ++i)
#pragma unroll
          for (int G = 0; G < 8; ++G) { float a = 0.f, v = 0.f;
#pragma unroll
              for (int jj = 0; jj < 4; ++jj) { a += wq[i][jj] * wif[(size_t)(c + jj) * 8 + G] + wk[i][jj] * wif[(size_t)(1024 + c + jj) * 8 + G]; v += wv[i][jj] * wif[(size_t)(2048 + c + jj) * 8 + G]; }
              EQ[(i * 8 + G) * 256 + g] = a; EV[(i * 8 + G) * 256 + g] = v; } }
    const bf16_t* zp = Z + (size_t)row0 * OD_N + c;
    float x3[4] = {0.f, 0.f, 0.f, 0.f}, x2[4] = {0.f, 0.f, 0.f, 0.f}, x1[4] = {0.f, 0.f, 0.f, 0.f};
    if (pos0 >= 3) { const u32x2 w = *(const u32x2*)(zp + (ptrdiff_t)(t0 - 3) * OD_N); x3[0] = bflo(w.x); x3[1] = bfhi(w.x); x3[2] = bflo(w.y); x3[3] = bfhi(w.y); }
    if (pos0 >= 2) { const u32x2 w = *(const u32x2*)(zp + (ptrdiff_t)(t0 - 2) * OD_N); x2[0] = bflo(w.x); x2[1] = bfhi(w.x); x2[2] = bflo(w.y); x2[3] = bfhi(w.y); }
    if (pos0 >= 1) { const u32x2 w = *(const u32x2*)(zp + (ptrdiff_t)(t0 - 1) * OD_N); x1[0] = bflo(w.x); x1[1] = bfhi(w.x); x1[2] = bflo(w.y); x1[3] = bfhi(w.y); }
    bf16_t* XC = GP(bf16_t, WS_XC) + (size_t)row0 * 1024 + c; bf16_t* Qb = GP(bf16_t, WS_Q) + (size_t)row0 * 1024 + c; bf16_t* Kb = GP(bf16_t, WS_KB) + (size_t)row0 * 1024 + c; bf16_t* Vb = GP(bf16_t, WS_V) + (size_t)row0 * 1024 + c;
    for (int i = 0; i < 32; ++i) { const int t = t0 + i;
        const u32x2 w = *(const u32x2*)(zp + (size_t)t * OD_N); float xm[4] = {bflo(w.x), bfhi(w.x), bflo(w.y), bfhi(w.y)}; float xc[4], q[4], k[4], v[4];
#pragma unroll
        for (int ch = 0; ch < 4; ++ch) { const float a = cw[0][ch] * x3[ch] + cw[1][ch] * x2[ch] + cw[2][ch] * x1[ch] + cw[3][ch] * xm[ch] + cb[ch]; xc[ch] = pg8::silu_f(a); x3[ch] = x2[ch]; x2[ch] = x1[ch]; x1[ch] = xm[ch]; }
#pragma unroll
        for (int jj = 0; jj < 4; ++jj) { q[jj] = xc[0] * wq[0][jj] + xc[1] * wq[1][jj] + xc[2] * wq[2][jj] + xc[3] * wq[3][jj]; k[jj] = xc[0] * wk[0][jj] + xc[1] * wk[1][jj] + xc[2] * wk[2][jj] + xc[3] * wk[3][jj];
            v[jj] = xm[0] * wv[0][jj] + xm[1] * wv[1][jj] + xm[2] * wv[2][jj] + xm[3] * wv[3][jj]; }
        { u32x2 o; o.x = pk2(xc[0], xc[1]); o.y = pk2(xc[2], xc[3]); *(u32x2*)(XC + (size_t)t * 1024) = o; }
        { u32x2 o; o.x = pk2(q[0], q[1]); o.y = pk2(q[2], q[3]); *(u32x2*)(Qb + (size_t)t * 1024) = o; }
        { u32x2 o; o.x = pk2(k[0] * 0.0625f, k[1] * 0.0625f); o.y = pk2(k[2] * 0.0625f, k[3] * 0.0625f); *(u32x2*)(Kb + (size_t)t * 1024) = o; }
        { u32x2 o; o.x = pk2(v[0], v[1]); o.y = pk2(v[2], v[3]); *(u32x2*)(Vb + (size_t)t * 1024) = o; }
#pragma unroll
        for (int G = 0; G < 8; ++G) { float gp = (xc[0] * EQ[(0 * 8 + G) * 256 + g] + xc[1] * EQ[(1 * 8 + G) * 256 + g]) + (xc[2] * EQ[(2 * 8 + G) * 256 + g] + xc[3] * EQ[(3 * 8 + G) * 256 + g]) + (xm[0] * EV[(0 * 8 + G) * 256 + g] + xm[1] * EV[(1 * 8 + G) * 256 + g]) + (xm[2] * EV[(2 * 8 + G) * 256 + g] + xm[3] * EV[(3 * 8 + G) * 256 + g]);
            gp = wave_sum(gp); if (lane == 0) RED[(t * 4 + (wave & 3)) * 8 + G] = gp; }
    }
    __syncthreads();
    { const int t = tid >> 3, G = tid & 7; const float s = p.in[I_MBIF][j * 8 + G] + (RED[(t * 4 + 0) * 8 + G] + RED[(t * 4 + 1) * 8 + G]) + (RED[(t * 4 + 2) * 8 + G] + RED[(t * 4 + 3) * 8 + G]);
      GP(float, WS_GATES)[(size_t)(row0 + t) * 8 + G] = s; }
    __syncthreads();
}

__device__ __forceinline__ void pool_unit(const KP& p, int j, int b, int n, int g, LAS unsigned char* lds) {
    const int tid = threadIdx.x, lane = tid & 63, wave = tid >> 6;
    LAS bf16_t* A = (LAS bf16_t*)lds;
    const bf16_t* Z = GP(const bf16_t, WS_HB);
    const int row0 = b * SEQ + n * 64;
    { const int c = tid & 255, th = tid >> 8, win = 2 << g, t0 = th * 32, pos0 = n * 64 + t0;
      const bf16_t* zp = Z + (size_t)row0 * OD_N + 2048 + g * 256 + c;
      float S = 0.f;
      for (int k = 1; k < win; ++k) if (pos0 - k >= 0) S += bf2f(zp[(ptrdiff_t)(t0 - k) * OD_N]);
      for (int i = 0; i < 32; ++i) { const int t = t0 + i, pos = pos0 + i; const float xv = bf2f(zp[(size_t)t * OD_N]); S += xv;
          const float cnt = (float)((pos + 1 < win) ? pos + 1 : win); A[t * 264 + c] = f2bf(S / cnt - xv);
          if (pos - win + 1 >= 0) S -= bf2f(zp[(ptrdiff_t)(t - win + 1) * OD_N]); } }
    __syncthreads();
    { const bf16_t* PT = GP(const bf16_t, WS_POOLT) + (size_t)g * 65536; f32x4 acc[2][4];
#pragma unroll
      for (int jt = 0; jt < 2; ++jt)
#pragma unroll
          for (int tt = 0; tt < 4; ++tt) acc[jt][tt] = F4ZERO;
#pragma unroll
      for (int ks = 0; ks < 8; ++ks) {
          bf16x8 bfr[4];
#pragma unroll
          for (int tt = 0; tt < 4; ++tt) bfr[tt] = lds_frag(A, 264, tt * 16, ks * 32, lane);
#pragma unroll
          for (int jt = 0; jt < 2; ++jt) { const bf16x8 a = glb_frag(PT, 256, (2 * wave + jt) * 16, ks * 32, lane);
#pragma unroll
              for (int tt = 0; tt < 4; ++tt) acc[jt][tt] = MFMA16(a, bfr[tt], acc[jt][tt]); } }
      bf16_t* MIX = GP(bf16_t, WS_U);
#pragma unroll
      for (int jt = 0; jt < 2; ++jt) { const int jj = (2 * wave + jt) * 16 + (lane >> 4) * 4; const f32x4 sc = *(const f32x4*)(p.in[I_POOLS] + j * 1024 + g * 256 + jj);
#pragma unroll
          for (int tt = 0; tt < 4; ++tt) { const int t = tt * 16 + (lane & 15); const f32x4 o = acc[jt][tt] * sc; u32x2 w; w.x = pk2(o[0], o[1]); w.y = pk2(o[2], o[3]);
              *(u32x2*)(MIX + (size_t)(row0 + t) * DM + 1024 + g * 256 + jj) = w; } } }
    __syncthreads();
}

__device__ __forceinline__ void mlstm_prep_unit(const KP& p, int b, int n, int h, LAS unsigned char* lds) {
    const int tid = threadIdx.x, lane = tid & 63, wave = tid >> 6;
    LAS bf16_t* Qs = (LAS bf16_t*)lds; LAS bf16_t* Ks = (LAS bf16_t*)(lds + 33792); LAS bf16_t* Vt = (LAS bf16_t*)(lds + 67584); LAS bf16_t* Ps = (LAS bf16_t*)(lds + 104448);
    LAS float* bc = (LAS float*)(lds + 113664); LAS float* ig = bc + 64; LAS float* ml = bc + 128; LAS float* wl = bc + 192; LAS float* denp = (LAS float*)(lds + 114688);
    const int row0 = b * SEQ + n * 64, ug = (b * NCH + n) * 4 + h;
    float* TOK = GP(float, WS_TOK);
    if (wave == 0) { const int t = lane; const float* gt = GP(const float, WS_GATES) + (size_t)(row0 + t) * 8; const float iv = gt[h], lf = logsigmoid_f(gt[4 + h]);
        float bcum = lf;
#pragma unroll
        for (int o = 1; o < 64; o <<= 1) { const float v = __shfl_up(bcum, o); if (lane >= o) bcum += v; }
        float pm = iv - bcum;
#pragma unroll
        for (int o = 1; o < 64; o <<= 1) { const float v = __shfl_up(pm, o); if (lane >= o) pm = fmaxf(pm, v); }
        const float mlv = bcum + pm, bL = __shfl(bcum, 63), gg = bL - bcum + iv, mg = wave_max(gg);
        bc[t] = bcum; ig[t] = iv; ml[t] = mlv; wl[t] = __expf(gg - mg);
        TOK[((size_t)(row0 + t) * 4 + h) * 4 + 0] = bcum; TOK[((size_t)(row0 + t) * 4 + h) * 4 + 1] = mlv;
        if (lane == 0) { GP(float, WS_SC)[ug * 2] = bL; GP(float, WS_SC)[ug * 2 + 1] = mg; } }
    { const int t = tid >> 3, seg = tid & 7; const u32x4* sq = (const u32x4*)(GP(const bf16_t, WS_Q) + (size_t)(row0 + t) * 1024 + h * 256 + seg * 32); const u32x4* sk = (const u32x4*)(GP(const bf16_t, WS_KB) + (size_t)(row0 + t) * 1024 + h * 256 + seg * 32);
      LAS u32x4* dq = (LAS u32x4*)(Qs + t * 264 + seg * 32); LAS u32x4* dk = (LAS u32x4*)(Ks + t * 264 + seg * 32);
#pragma unroll
      for (int k = 0; k < 4; ++k) { dq[k] = sq[k]; dk[k] = sk[k]; } }
    { const int jv = tid & 255, th = tid >> 8; const bf16_t* vp = GP(const bf16_t, WS_V) + (size_t)row0 * 1024 + h * 256 + jv;
#pragma unroll 8
      for (int i = 0; i < 32; ++i) { const int t = th * 32 + i; Vt[jv * 72 + t] = vp[(size_t)t * 1024]; } }
    __syncthreads();
    { const int tt = wave >> 1, stb = (wave & 1) * 2; f32x4 acc[2] = {F4ZERO, F4ZERO};
#pragma unroll
      for (int ks = 0; ks < 8; ++ks) { const bf16x8 a = lds_frag(Qs, 264, tt * 16, ks * 32, lane);
#pragma unroll
          for (int s2 = 0; s2 < 2; ++s2) { const bf16x8 bfr = lds_frag(Ks, 264, (stb + s2) * 16, ks * 32, lane); acc[s2] = MFMA16(a, bfr, acc[s2]); } }
#pragma unroll
      for (int s2 = 0; s2 < 2; ++s2) { const int s = (stb + s2) * 16 + (lane & 15); const float es = ig[s] - bc[s];
#pragma unroll
          for (int i = 0; i < 4; ++i) { const int t = tt * 16 + (lane >> 4) * 4 + i; float pv = (s <= t) ? acc[s2][i] * __expf(bc[t] + es - ml[t]) : 0.f; Ps[t * 72 + s] = f2bf(pv);
              pv += __shfl_xor(pv, 1); pv += __shfl_xor(pv, 2); pv += __shfl_xor(pv, 4); pv += __shfl_xor(pv, 8);
              if ((lane & 15) == 0) denp[t * 4 + stb + s2] = pv; } } }
    __syncthreads();
    { f32x4 acc[2][4];
#pragma unroll
      for (int jt = 0; jt < 2; ++jt)
#pragma unroll
          for (int tt = 0; tt < 4; ++tt) acc[jt][tt] = F4ZERO;
#pragma unroll
      for (int jt = 0; jt < 2; ++jt)
#pragma unroll
          for (int ks = 0; ks < 2; ++ks) { const bf16x8 a = lds_frag(Vt, 72, (2 * wave + jt) * 16, ks * 32, lane);
#pragma unroll
              for (int tt = 0; tt < 4; ++tt) { const bf16x8 bfr = lds_frag(Ps, 72, tt * 16, ks * 32, lane); acc[jt][tt] = MFMA16(a, bfr, acc[jt][tt]); } }
      float* NUM = GP(float, WS_HO);
#pragma unroll
      for (int jt = 0; jt < 2; ++jt)
#pragma unroll
          for (int tt = 0; tt < 4; ++tt) { const int jj = (2 * wave + jt) * 16 + (lane >> 4) * 4, t = tt * 16 + (lane & 15); *(f32x4*)(NUM + (size_t)(row0 + t) * 1024 + h * 256 + jj) = acc[jt][tt]; } }
    if (tid < 64) TOK[((size_t)(row0 + tid) * 4 + h) * 4 + 2] = (denp[tid * 4] + denp[tid * 4 + 1]) + (denp[tid * 4 + 2] + denp[tid * 4 + 3]);
    { const int jv = tid >> 1, half = tid & 1; unsigned w[16];
#pragma unroll
      for (int k = 0; k < 16; ++k) { const int s = half * 32 + 2 * k; w[k] = pk2(bf2f(Vt[jv * 72 + s]) * wl[s], bf2f(Vt[jv * 72 + s + 1]) * wl[s + 1]); }
      u32x4* dst = (u32x4*)(GP(bf16_t, WS_WVT) + (size_t)ug * 16384 + jv * 64 + half * 32);
#pragma unroll
      for (int k = 0; k < 4; ++k) dst[k] = (u32x4){w[4 * k], w[4 * k + 1], w[4 * k + 2], w[4 * k + 3]}; }
    { const int d = tid >> 1, half = tid & 1; unsigned w[16];
#pragma unroll
      for (int k = 0; k < 16; ++k) { const int s = half * 32 + 2 * k; w[k] = (unsigned)Ks[s * 264 + d] | ((unsigned)Ks[(s + 1) * 264 + d] << 16); }
      u32x4* dst = (u32x4*)(GP(bf16_t, WS_KT) + (size_t)ug * 16384 + d * 64 + half * 32);
#pragma unroll
      for (int k = 0; k < 4; ++k) dst[k] = (u32x4){w[4 * k], w[4 * k + 1], w[4 * k + 2], w[4 * k + 3]}; }
    if (tid < 256) { float s = 0.f;
#pragma unroll 8
        for (int t = 0; t < 64; ++t) s += wl[t] * bf2f(Ks[t * 264 + tid]);
        GP(float, WS_NU)[(size_t)ug * 256 + tid] = s; }
    __syncthreads();
}

__device__ __forceinline__ void mlstm_scan_unit(const KP& p, int b, int h, int vs, LAS unsigned char* lds) {
    const int tid = threadIdx.x, lane = tid & 63, wave = tid >> 6;
    LAS bf16_t* Qs = (LAS bf16_t*)lds; LAS bf16_t* KTs = (LAS bf16_t*)(lds + 33792); LAS bf16_t* WVs = (LAS bf16_t*)(lds + 70656); LAS bf16_t* Cs = (LAS bf16_t*)(lds + 75264);
    LAS float* nvec = (LAS float*)(lds + 92160); LAS float* qnp = (LAS float*)(lds + 93184); LAS float* tokf = (LAS float*)(lds + 95232); LAS float* nUs = (LAS float*)(lds + 96256);
    const bf16_t* Qg = GP(const bf16_t, WS_Q); const bf16_t* KTg = GP(const bf16_t, WS_KT); const bf16_t* WVTg = GP(const bf16_t, WS_WVT);
    const float* TOK = GP(const float, WS_TOK); const float* SC = GP(const float, WS_SC); const float* NU = GP(const float, WS_NU); float* NUM = GP(float, WS_HO);
    f32x4 Cacc[2][2] = {{F4ZERO, F4ZERO}, {F4ZERO, F4ZERO}}; float nreg = 0.f, m = 0.f;
    for (int i = tid; i < 32 * 264 / 2; i += NTHREADS) ((LAS unsigned*)Cs)[i] = 0u;
    if (tid < 256) nvec[tid] = 0.f;
    u32x4 rq[4], rk[4], rw = (u32x4){0u, 0u, 0u, 0u}; f32x4 rtok = F4ZERO; float rnu = 0.f, rbL = 0.f, rmg = 0.f;
#define ML_LOAD(nn) do { const int row0_ = b * SEQ + (nn) * 64; const size_t ug_ = (size_t)((b * NCH + (nn)) * 4 + h); \
        { const u32x4* s_ = (const u32x4*)(Qg + (size_t)(row0_ + (tid >> 3)) * 1024 + h * 256 + (tid & 7) * 32); rq[0] = s_[0]; rq[1] = s_[1]; rq[2] = s_[2]; rq[3] = s_[3]; } \
        { const u32x4* s_ = (const u32x4*)(KTg + ug_ * 16384 + (tid >> 1) * 64 + (tid & 1) * 32); rk[0] = s_[0]; rk[1] = s_[1]; rk[2] = s_[2]; rk[3] = s_[3]; } \
        if (tid < 256) { rw = *(const u32x4*)(WVTg + ug_ * 16384 + (size_t)(vs * 32 + (tid >> 3)) * 64 + (tid & 7) * 8); rnu = NU[ug_ * 256 + tid]; } \
        if (tid < 64) rtok = *(const f32x4*)(TOK + ((size_t)(row0_ + tid) * 4 + h) * 4); \
        rbL = SC[ug_ * 2]; rmg = SC[ug_ * 2 + 1]; } while (0)
    ML_LOAD(0);
    for (int n = 0; n < NCH; ++n) {
        const int row0 = b * SEQ + n * 64;
        { LAS u32x4* d_ = (LAS u32x4*)(Qs + (tid >> 3) * 264 + (tid & 7) * 32); d_[0] = rq[0]; d_[1] = rq[1]; d_[2] = rq[2]; d_[3] = rq[3]; }
        { LAS u32x4* d_ = (LAS u32x4*)(KTs + (tid >> 1) * 72 + (tid & 1) * 32); d_[0] = rk[0]; d_[1] = rk[1]; d_[2] = rk[2]; d_[3] = rk[3]; }
        if (tid < 256) { *(LAS u32x4*)(WVs + (tid >> 3) * 72 + (tid & 7) * 8) = rw; nUs[tid] = rnu; }
        if (tid < 64) *(LAS f32x4*)(tokf + tid * 4) = rtok;
        const float bL = rbL, mg = rmg;
        __syncthreads();
        if (n + 1 < NCH) ML_LOAD(n + 1);
        const int jt = wave >> 2, tt = wave & 3; f32x4 acc = F4ZERO;
#pragma unroll
        for (int ks = 0; ks < 8; ++ks) { const bf16x8 a = lds_frag(Cs, 264, jt * 16, ks * 32, lane), bfr = lds_frag(Qs, 264, tt * 16, ks * 32, lane); acc = MFMA16(a, bfr, acc); }
        { const int t = tid & 63, part = tid >> 6; float s = 0.f;
#pragma unroll
          for (int dd = 0; dd < 32; dd += 2) { const unsigned w = *(const LAS unsigned*)(Qs + t * 264 + part * 32 + dd); s += bflo(w) * nvec[part * 32 + dd] + bfhi(w) * nvec[part * 32 + dd + 1]; }
          qnp[part * 64 + t] = s; }
        f32x4 tmp[2][2] = {{F4ZERO, F4ZERO}, {F4ZERO, F4ZERO}};
#pragma unroll
        for (int dt = 0; dt < 2; ++dt)
#pragma unroll
            for (int ks = 0; ks < 2; ++ks) { const bf16x8 a = lds_frag(KTs, 72, (2 * wave + dt) * 16, ks * 32, lane);
#pragma unroll
                for (int j2 = 0; j2 < 2; ++j2) { const bf16x8 bfr = lds_frag(WVs, 72, j2 * 16, ks * 32, lane); tmp[dt][j2] = MFMA16(a, bfr, tmp[dt][j2]); } }
        const float m_new = fmaxf(bL + m, mg), decay = __expf(bL + m - m_new), sc = __expf(mg - m_new);
#pragma unroll
        for (int dt = 0; dt < 2; ++dt)
#pragma unroll
            for (int j2 = 0; j2 < 2; ++j2) Cacc[dt][j2] = Cacc[dt][j2] * decay + tmp[dt][j2] * sc;
        if (tid < 256) nreg = decay * nreg + sc * nUs[tid];
        const int te = tt * 16 + (lane & 15); const f32x4 tk = *(const LAS f32x4*)(tokf + te * 4);
        __syncthreads();
        { float qn = 0.f;
#pragma unroll
          for (int pp = 0; pp < 8; ++pp) qn += qnp[pp * 64 + te];
          const float mt = fmaxf(tk[0] + m, tk[1]), el = __expf(tk[1] - mt), ei = __expf(tk[0] + m - mt), den = el * tk[2] + ei * qn, inv = 1.0f / fmaxf(fabsf(den), __expf(-mt));
          const int jj = vs * 32 + jt * 16 + (lane >> 4) * 4; f32x4* np_ = (f32x4*)(NUM + (size_t)(row0 + te) * 1024 + h * 256 + jj); const f32x4 nl = *np_; *np_ = (nl * el + acc * ei) * inv; }
#pragma unroll
        for (int dt = 0; dt < 2; ++dt)
#pragma unroll
            for (int j2 = 0; j2 < 2; ++j2) { const int jcol = j2 * 16 + (lane & 15), d0 = (2 * wave + dt) * 16 + (lane >> 4) * 4; u32x2 w; w.x = pk2(Cacc[dt][j2][0], Cacc[dt][j2][1]); w.y = pk2(Cacc[dt][j2][2], Cacc[dt][j2][3]);
                *(LAS u32x2*)(Cs + jcol * 264 + d0) = w; }
        if (tid < 256) nvec[tid] = nreg;
        m = m_new;
    }
#undef ML_LOAD
    __syncthreads();
}

__device__ __forceinline__ void ph_mlstm_final(const KP& p, int j) {
    const int tid = threadIdx.x, lane = tid & 63, wave = tid >> 6;
    const int gw = blockIdx.x * NWAVES + wave, NGW = gridDim.x * NWAVES;
    const float* NUM = GP(const float, WS_HO); const bf16_t* Z = GP(const bf16_t, WS_HB); const bf16_t* XC = GP(const bf16_t, WS_XC); bf16_t* MIX = GP(bf16_t, WS_U);
    for (int row = gw; row < M; row += NGW) {
#pragma unroll
        for (int h = 0; h < 4; ++h) { const int c = h * 256 + lane * 4; const f32x4 o = *(const f32x4*)(NUM + (size_t)row * 1024 + c);
            const float ss = wave_sum((o[0] * o[0] + o[1] * o[1]) + (o[2] * o[2] + o[3] * o[3])); const float rs = rsqrtf(ss * (1.0f / 256.0f) + EPS);
            const f32x4 mn = *(const f32x4*)(p.in[I_MNORM] + j * 1024 + c), sk = *(const f32x4*)(p.in[I_MSKIP] + j * 1024 + c);
            const u32x2 xw = *(const u32x2*)(XC + (size_t)row * 1024 + c), zw = *(const u32x2*)(Z + (size_t)row * OD_N + 1024 + c);
            const float x0 = bflo(xw.x), x1 = bfhi(xw.x), x2 = bflo(xw.y), x3 = bfhi(xw.y), z0 = bflo(zw.x), z1 = bfhi(zw.x), z2 = bflo(zw.y), z3 = bfhi(zw.y);
            u32x2 w; w.x = pk2(sigmoid_f(z0) * (o[0] * rs * mn[0] + sk[0] * x0), sigmoid_f(z1) * (o[1] * rs * mn[1] + sk[1] * x1));
            w.y = pk2(sigmoid_f(z2) * (o[2] * rs * mn[2] + sk[2] * x2), sigmoid_f(z3) * (o[3] * rs * mn[3] + sk[3] * x3));
            *(u32x2*)(MIX + (size_t)row * DM + c) = w; }
    }
}

enum Phase { PH_INIT = 0, PH_FFN1, PH_FFN2, PH_FNORM, PH_MIN, PH_E2, PH_E3, PH_E4, PH_O2, PH_O3, PH_O4, PH_O5, PH_MOUT, PH_MNORM };

template <int PH> __device__ __forceinline__ void run_phase(const KP& p, int l, int s, LAS unsigned char* lds) {
    const int j = l >> 1, G = gridDim.x, blk = blockIdx.x;
    const float* ng = p.in[I_NORMG] + (size_t)l * 6 * DM;
    if constexpr (PH == PH_INIT) {
        ph_norm(p.in[I_X], p.out, nullptr, 0.f, nullptr, p.in[I_NORMG], GP(bf16_t, WS_U));
        ph_weights(p, 0, lds);
    } else if constexpr (PH == PH_FFN1) {
        pg8::Gemm g{GP(const bf16_t, WS_U), GP(const bf16_t, s ? WS_W1B : WS_W1A), M, 2 * DFF, DM}; pg8::StaticOrder S; S.init(M, 2 * DFF, G, blk);
        pg8::EpiSwiglu E{GP(bf16_t, WS_HB), DFF};
        pg8::gemm_phase<pg8::EpiSwiglu, pg8::StaticOrder, true, true>(lds, g, S, E);
    } else if constexpr (PH == PH_FFN2) {
        pg8::Gemm g{GP(const bf16_t, WS_HB), GP(const bf16_t, s ? WS_W2B : WS_W2A), M, DM, DFF}; pg8::StaticOrder S; S.init(M, DM, G, blk);
        pg8::EpiBf16P E{GP(bf16_t, WS_HO), DM};
        pg8::gemm_phase<pg8::EpiBf16P, pg8::StaticOrder, true, true>(lds, g, S, E);
    } else if constexpr (PH == PH_FNORM) {
        const float* ga = ng + (s ? 5 : 1) * DM; const float* gb = s ? (ng + 6 * DM) : (ng + 2 * DM); const bool last = (s == 1 && l == DEPTH - 1);
        ph_norm(p.out, p.out, GP(const bf16_t, WS_HO), 0.5f, ga, last ? nullptr : gb, last ? nullptr : GP(bf16_t, WS_U));
        if (s == 1 && l + 1 < DEPTH) ph_weights(p, l + 1, lds);
    } else if constexpr (PH == PH_MIN) {
        const int N = (l & 1) ? OD_N : EV_NP;
        pg8::Gemm g{GP(const bf16_t, WS_U), GP(const bf16_t, WS_WIN), M, N, DM}; pg8::StaticOrder S; S.init(M, N, G, blk);
        pg8::EpiBf16P E{GP(bf16_t, WS_HB), N};
        pg8::gemm_phase<pg8::EpiBf16P, pg8::StaticOrder, true, true>(lds, g, S, E);
    } else if constexpr (PH == PH_E2) {
        for (int u = blk; u < BATCH * NCH * 4; u += G) gla_prep_unit(p, j, u >> 9, (u >> 2) & 127, u & 3, lds);
        for (int u = blk; u < BATCH * NCH * 8; u += G) lru_local_unit(p, j, u >> 10, (u >> 3) & 127, u & 7, lds);
    } else if constexpr (PH == PH_E3) {
        const int nscan = BATCH * 4 * 8;
        if (G > nscan) { if (blk < nscan) gla_scan_unit(p, blk >> 5, (blk >> 3) & 3, blk & 7, lds); else for (int u = blk - nscan; u < BATCH * NCH; u += G - nscan) lru_fix_unit(p, u >> 7, u & 127); }
        else { for (int u = blk; u < nscan; u += G) gla_scan_unit(p, u >> 5, (u >> 3) & 3, u & 7, lds); for (int u = blk; u < BATCH * NCH; u += G) lru_fix_unit(p, u >> 7, u & 127); }
    } else if constexpr (PH == PH_E4) {
        ph_gla_final(p, j);
    } else if constexpr (PH == PH_O2) {
        for (int u = blk; u < BATCH * NCH; u += G) mlstm_tok_unit(p, j, u >> 7, u & 127, lds);
    } else if constexpr (PH == PH_O3) {
        for (int u = blk; u < BATCH * NCH * 4; u += G) mlstm_prep_unit(p, u >> 9, (u >> 2) & 127, u & 3, lds);
    } else if constexpr (PH == PH_O4) {
        const int nscan = BATCH * 4 * 8;
        if (G > nscan) { if (blk < nscan) mlstm_scan_unit(p, blk >> 5, (blk >> 3) & 3, blk & 7, lds); else for (int u = blk - nscan; u < BATCH * NCH * 4; u += G - nscan) pool_unit(p, j, u >> 9, (u >> 2) & 127, u & 3, lds); }
        else { for (int u = blk; u < nscan; u += G) mlstm_scan_unit(p, u >> 5, (u >> 3) & 3, u & 7, lds); for (int u = blk; u < BATCH * NCH * 4; u += G) pool_unit(p, j, u >> 9, (u >> 2) & 127, u & 3, lds); }
    } else if constexpr (PH == PH_O5) {
        ph_mlstm_final(p, j);
    } else if constexpr (PH == PH_MOUT) {
        pg8::Gemm g{GP(const bf16_t, WS_U), GP(const bf16_t, WS_WOUT), M, DM, DM}; pg8::StaticOrder S; S.init(M, DM, G, blk);
        pg8::EpiBf16P E{GP(bf16_t, WS_HO), DM};
        pg8::gemm_phase<pg8::EpiBf16P, pg8::StaticOrder, true, true>(lds, g, S, E);
    } else if constexpr (PH == PH_MNORM) {
        ph_norm(p.out, p.out, GP(const bf16_t, WS_HO), 1.0f, ng + 3 * DM, ng + 4 * DM, GP(bf16_t, WS_U));
    }
}

template <int PH> __global__ void __launch_bounds__(NTHREADS, 2) k_phase(KP p, int l, int s) {
    extern __shared__ __attribute__((aligned(16))) unsigned char smem[];
    run_phase<PH>(p, l, s, (LAS unsigned char*)smem);
}

template <int PH> static void launch_phase(const KP& p, int l, int s, hipStream_t st) {
    static bool attr = false;
    if (!attr) { (void)hipFuncSetAttribute((const void*)k_phase<PH>, hipFuncAttributeMaxDynamicSharedMemorySize, LDS_BYTES); attr = true; }
    hipLaunchKernelGGL((k_phase<PH>), dim3(256), dim3(NTHREADS), LDS_BYTES, st, p, l, s);
}

extern "C" void kernel_launch(void* const* d_in, const int* in_sizes, int n_in, void* d_out, int out_size, void* d_ws, size_t ws_size, hipStream_t stream) {
    if (n_in != 30 || ws_size < WS_END) { fprintf(stderr, "kernel_launch: unexpected n_in %d or ws_size %zu (< %zu)\n", n_in, ws_size, (size_t)WS_END); return; }
    KP p{};
    for (int i = 0; i < 30; ++i) p.in[i] = (const float*)d_in[i];
    p.out = (float*)d_out; p.ws = (unsigned char*)d_ws;
    launch_phase<PH_INIT>(p, 0, 0, stream);
    for (int l = 0; l < DEPTH; ++l) {
        launch_phase<PH_FFN1>(p, l, 0, stream); launch_phase<PH_FFN2>(p, l, 0, stream); launch_phase<PH_FNORM>(p, l, 0, stream);
        launch_phase<PH_MIN>(p, l, 0, stream);
        if ((l & 1) == 0) { launch_phase<PH_E2>(p, l, 0, stream); launch_phase<PH_E3>(p, l, 0, stream); launch_phase<PH_E4>(p, l, 0, stream); }
        else { launch_phase<PH_O2>(p, l, 0, stream); launch_phase<PH_O3>(p, l, 0, stream); launch_phase<PH_O4>(p, l, 0, stream); launch_phase<PH_O5>(p, l, 0, stream); }
        launch_phase<PH_MOUT>(p, l, 0, stream); launch_phase<PH_MNORM>(p, l, 0, stream);
        launch_phase<PH_FFN1>(p, l, 1, stream); launch_phase<PH_FFN2>(p, l, 1, stream); launch_phase<PH_FNORM>(p, l, 1, stream);
    }
}
```

```cpp
#include <hip/hip_runtime.h>
#include <cstdio>
#include <cstdint>
__device__ __forceinline__ int otid() { int t = (int)threadIdx.x; asm volatile("" : "+v"(t)); return t; }
__device__ __forceinline__ int obid() { int b = (int)blockIdx.x; asm volatile("" : "+s"(b)); return b; }
namespace pg8 {
#define PG8_LAS __attribute__((address_space(3)))
typedef unsigned short bf16_t;
typedef short bf16x8 __attribute__((ext_vector_type(8)));
typedef float f32x4 __attribute__((ext_vector_type(4)));
typedef unsigned u32x4 __attribute__((ext_vector_type(4)));
constexpr int BM = 256, BK = 64, HALF = 128, HTB = HALF * BK * 2  , STAGE_BYTES = 8 * HTB, NXCD = 8, WGM = 4;

__host__ __device__ __forceinline__ int lds_byte(int r, int c) { const int st = (r >> 4) * 2 + (c >> 5), rr = r & 15, cc = c & 31, ob = rr * 64 + cc * 2; return st * 1024 + (ob ^ (((ob >> 9) & 1) << 5)); }
__host__ __device__ __forceinline__ void stage_rc(int b, int& R, int& C) { const int st = b / 1024, sb = b % 1024, swz = sb ^ (((sb >> 9) & 1) << 5); R = (st >> 1) * 16 + swz / 64; C = (st & 1) * 32 + (swz % 64) / 2; }
__host__ __device__ __forceinline__ int perm32(int rho) { const int n = rho >> 4, i = rho & 15; return 8 * (i >> 2) + 4 * n + (i & 3); }

struct Unit { int pm, pn; };
struct Gemm { const bf16_t* A; const bf16_t* Bt; int M, N, K; };

struct StaticOrder {
    int nM, nN, nwg, G, c, wgm;
    __host__ __device__ void init(int M, int N, int G_, int c_, int wgm_ = WGM) { nM = M / BM; nN = N / BM; nwg = nM * nN; G = G_; c = c_; wgm = wgm_; }
    __host__ __device__ bool next(int i, Unit& u) const {
        const long L = (long)i * G + c; if (L >= nwg) return false;
        int wgid = (int)L; { const int q = nwg / NXCD, r = nwg % NXCD, xcd = wgid % NXCD, off = wgid / NXCD; wgid = (xcd < r ? xcd * (q + 1) : r * (q + 1) + (xcd - r) * q) + off; }
        const int nig = wgm * nN, gid = wgid / nig, fm = gid * wgm, gsz = (nM - fm) < wgm ? (nM - fm) : wgm;
        u.pm = fm + ((wgid % nig) % gsz); u.pn = (wgid % nig) / gsz; return true;
    }
    __device__ __forceinline__ void a_ready(const Unit&) const {}
    __device__ __forceinline__ void done(const Unit&) const {}
};

__device__ __forceinline__ unsigned cvt_pk_bf16(float lo, float hi) { unsigned r; asm volatile("v_cvt_pk_bf16_f32 %0, %1, %2" : "=v"(r) : "v"(lo), "v"(hi)); return r; }
typedef float f32x2 __attribute__((ext_vector_type(2)));
__device__ __forceinline__ float silu_f(float x) { return x * __builtin_amdgcn_rcpf(1.0f + __expf(-x)); }
struct EpiSwiglu {
    static constexpr bool PERM = true, AFTER_DRAIN = false;
    bf16_t* O; int ldc; const float* rs;
    __device__ __forceinline__ void stage(const Unit& u, PG8_LAS unsigned char* area, int wr, int lane) const {
        const float* src = rs + u.pm * BM + wr * 64 + lane;
        __builtin_amdgcn_global_load_lds((const unsigned*)src, (PG8_LAS unsigned*)area, 4, 0, 0);
        __builtin_amdgcn_global_load_lds((const unsigned*)(src + HALF), (PG8_LAS unsigned*)(area + 256), 4, 0, 0);
    }
    __device__ __forceinline__ void operator()(const f32x4 (&acc)[2][2][4][2], const Unit& u, int wr, int wc, int fr, int fq, const PG8_LAS unsigned char* area) const {
        const int row0 = u.pm * BM + wr * 64 + fr, col0 = u.pn * HALF + wc * 32 + 8 * fq; (void)row0;
        bf16_t* const obase = O + (((size_t)u.pm * (ldc / BK) + 2 * u.pn + (wc >> 1)) * BM + wr * 64 + fr) * BK + (wc & 1) * 32 + 8 * fq;
        float rsv[2][4];
#pragma unroll
        for (int ai = 0; ai < 2; ++ai)
#pragma unroll
            for (int m = 0; m < 4; ++m) rsv[ai][m] = *(const PG8_LAS float*)(area + ai * 256 + (m * 16 + fr) * 4);
#pragma unroll
        for (int ai = 0; ai < 2; ++ai)
#pragma unroll
            for (int m = 0; m < 4; ++m) { bf16_t* rowp = obase + (ai * HALF + m * 16) * BK; const float r_ = rsv[ai][m], r2 = r_ * -1.4426950408889634f, rr = r_ * r_;
                const f32x4 t0 = acc[ai][0][m][0] * r2, t1 = acc[ai][0][m][1] * r2;
                f32x4 d0, d1, q0, q1;
#pragma unroll
                for (int i = 0; i < 4; ++i) { d0[i] = __builtin_amdgcn_exp2f(t0[i]); d1[i] = __builtin_amdgcn_exp2f(t1[i]); }
                d0 = d0 + 1.0f; d1 = d1 + 1.0f;
#pragma unroll
                for (int i = 0; i < 4; ++i) { q0[i] = __builtin_amdgcn_rcpf(d0[i]); q1[i] = __builtin_amdgcn_rcpf(d1[i]); }
                const f32x4 o0 = (acc[ai][0][m][0] * acc[ai][1][m][0]) * rr * q0, o1 = (acc[ai][0][m][1] * acc[ai][1][m][1]) * rr * q1;
                u32x4 w; w.x = cvt_pk_bf16(o0[0], o0[1]); w.y = cvt_pk_bf16(o0[2], o0[3]); w.z = cvt_pk_bf16(o1[0], o1[1]); w.w = cvt_pk_bf16(o1[2], o1[3]);
                *(u32x4*)rowp = w; }
    }
};
struct EpiBf16P {
    static constexpr bool PERM = true, AFTER_DRAIN = false;
    bf16_t* O; int ldc; const float* rs;
    __device__ __forceinline__ void stage(const Unit& u, PG8_LAS unsigned char* area, int wr, int lane) const {
        if (rs) { const float* src = rs + u.pm * BM + wr * 64 + lane;
            __builtin_amdgcn_global_load_lds((const unsigned*)src, (PG8_LAS unsigned*)area, 4, 0, 0);
            __builtin_amdgcn_global_load_lds((const unsigned*)(src + HALF), (PG8_LAS unsigned*)(area + 256), 4, 0, 0); }
    }
    __device__ __forceinline__ void operator()(const f32x4 (&acc)[2][2][4][2], const Unit& u, int wr, int wc, int fr, int fq, const PG8_LAS unsigned char* area) const {
        const int row0 = u.pm * BM + wr * 64 + fr, col0 = u.pn * BM + wc * 32 + 8 * fq;
        float rsv[2][4];
#pragma unroll
        for (int ai = 0; ai < 2; ++ai)
#pragma unroll
            for (int m = 0; m < 4; ++m) rsv[ai][m] = rs ? *(const PG8_LAS float*)(area + ai * 256 + (m * 16 + fr) * 4) : 1.0f;
#pragma unroll
        for (int ai = 0; ai < 2; ++ai)
#pragma unroll
            for (int m = 0; m < 4; ++m) { bf16_t* rowp = O + (size_t)(row0 + ai * HALF + m * 16) * ldc + col0; const float r_ = rsv[ai][m];
#pragma unroll
                for (int bj = 0; bj < 2; ++bj) { const f32x4 v0 = acc[ai][bj][m][0] * r_, v1 = acc[ai][bj][m][1] * r_;
                    u32x4 w; w.x = cvt_pk_bf16(v0[0], v0[1]); w.y = cvt_pk_bf16(v0[2], v0[3]); w.z = cvt_pk_bf16(v1[0], v1[1]); w.w = cvt_pk_bf16(v1[2], v1[3]);
                    *(u32x4*)(rowp + bj * HALF) = w; } }
    }
};

template <class Epi, class Sched, bool ALIGN_EPI = false, bool SP2 = false, bool ABLK = false, bool BBLK = false>
__device__ __forceinline__ void gemm_phase(PG8_LAS unsigned char* lds, const Gemm g, const Sched& S, const Epi& E) {
    const int tid = otid(), wid = __builtin_amdgcn_readfirstlane(tid >> 6), lane = tid & 63, wr = wid >> 2, wc = wid & 3, fr = lane & 15, fq = lane >> 4;
    const int K = g.K, nt = K / BK;
    unsigned voffA[2], voffB[2];
#pragma unroll
    for (int i = 0; i < 2; ++i) { int R, C; stage_rc(tid * 16 + i * 8192, R, C); const int Rb = Epi::PERM ? ((R & ~31) + perm32(R & 31)) : R;
        voffA[i] = ABLK ? (unsigned)(R * BK + C) * 2u : (unsigned)(R * K + C) * 2u; voffB[i] = BBLK ? (unsigned)(Rb * BK + C) * 2u : (unsigned)(Rb * K + C) * 2u; }
    const size_t kstepB = BBLK ? (size_t)BM * BK * 2 : (size_t)(BK * 2), kstepA = ABLK ? (size_t)BM * BK * 2 : (size_t)(BK * 2);
    const size_t hstepB = BBLK ? (size_t)HALF * BK * 2 : (size_t)HALF * K * 2, hstepA = ABLK ? (size_t)HALF * BK * 2 : (size_t)HALF * K * 2;
    const size_t tstep = (size_t)BM * K * 2;
    const unsigned ldsw = (unsigned)wid * 1024u;
    const int aoff = lds_byte(wr * 64 + fr, fq * 8), boff = lds_byte(wc * 32 + fr, fq * 8);
#define PG8_SA(b, h) (((b) * 2 + (h)) * HTB)
#define PG8_SB(b, h) ((4 + (b) * 2 + (h)) * HTB)
#define PG8_STAGE(bufoff, gbase, voff) do { _Pragma("unroll") for (int _i = 0; _i < 2; ++_i) \
        __builtin_amdgcn_global_load_lds((const unsigned*)((const char*)(gbase) + (voff)[_i]), (PG8_LAS unsigned*)(lds + (bufoff) + ldsw + _i * 8192), 16, 0, 0); } while (0)
#define PG8_LDA(dst, b, h) do { _Pragma("unroll") for (int m = 0; m < 4; ++m) _Pragma("unroll") for (int k = 0; k < 2; ++k) dst[m][k] = *(const PG8_LAS bf16x8*)(lds + PG8_SA(b, h) + aoff + m * 2048 + k * 1024); } while (0)
#define PG8_LDB(dst, b, h) do { _Pragma("unroll") for (int n = 0; n < 2; ++n) _Pragma("unroll") for (int k = 0; k < 2; ++k) dst[n][k] = *(const PG8_LAS bf16x8*)(lds + PG8_SB(b, h) + boff + n * 2048 + k * 1024); } while (0)
#define PG8_MMA(ai, bj, At, Bt) do { __builtin_amdgcn_s_setprio(1); _Pragma("unroll") for (int m = 0; m < 4; ++m) _Pragma("unroll") for (int n = 0; n < 2; ++n) _Pragma("unroll") for (int k = 0; k < 2; ++k) \
        acc[ai][bj][m][n] = __builtin_amdgcn_mfma_f32_16x16x32_bf16(Bt[n][k], At[m][k], acc[ai][bj][m][n], 0, 0, 0); __builtin_amdgcn_s_setprio(0); } while (0)
#define PG8_WAIT_V(n) asm volatile("s_waitcnt vmcnt(" #n ")" ::: "memory")
#define PG8_WAIT_L(n) asm volatile("s_waitcnt lgkmcnt(" #n ")" ::: "memory")
#define PG8_BAR __builtin_amdgcn_s_barrier()
#define PG8_SCHED __builtin_amdgcn_sched_barrier(0)
    Unit cur, nxt; int ui = 0;
    if (!S.next(0, cur)) return;
    f32x4 acc[2][2][4][2];
#pragma unroll
    for (int a = 0; a < 2; ++a)
#pragma unroll
        for (int b = 0; b < 2; ++b)
#pragma unroll
            for (int m = 0; m < 4; ++m)
#pragma unroll
                for (int n = 0; n < 2; ++n) acc[a][b][m][n] = (f32x4){0.f, 0.f, 0.f, 0.f};
    bf16x8 At[4][2], B0[2][2], B1[2][2];
    const char* cA = (const char*)g.A + (size_t)cur.pm * tstep; const char* cB = (const char*)g.Bt + (size_t)cur.pn * tstep;
    S.a_ready(cur);
    if constexpr (SP2) {
        PG8_STAGE(PG8_SB(0, 0), cB, voffB); PG8_STAGE(PG8_SB(0, 1), cB + hstepB, voffB); PG8_STAGE(PG8_SA(0, 0), cA, voffA); PG8_STAGE(PG8_SA(0, 1), cA + hstepA, voffA);
        if (wr == 1) PG8_BAR;
        PG8_WAIT_V(2); PG8_BAR;
        PG8_STAGE(PG8_SB(1, 0), cB + kstepB, voffB); PG8_STAGE(PG8_SA(1, 0), cA + kstepA, voffA); PG8_STAGE(PG8_SB(1, 1), cB + hstepB + kstepB, voffB);
        PG8_WAIT_V(6); PG8_BAR;
    } else {
        PG8_STAGE(PG8_SB(0, 0), cB, voffB); PG8_STAGE(PG8_SA(0, 0), cA, voffA); PG8_STAGE(PG8_SB(0, 1), cB + hstepB, voffB); PG8_STAGE(PG8_SA(0, 1), cA + hstepA, voffA);
        if (wr == 1) PG8_BAR;
        PG8_WAIT_V(4); PG8_BAR;
        PG8_STAGE(PG8_SB(1, 0), cB + kstepB, voffB); PG8_STAGE(PG8_SA(1, 0), cA + kstepA, voffA); PG8_STAGE(PG8_SB(1, 1), cB + hstepB + kstepB, voffB);
        PG8_WAIT_V(6); PG8_BAR;
    }
    for (;;) {
        const bool has_next = S.next(ui + 1, nxt);
        PG8_LAS unsigned char* const rs_area = lds + STAGE_BYTES + wid * 512;
        E.stage(cur, rs_area, wr, lane);
        const char* nA = has_next ? (const char*)g.A + (size_t)nxt.pm * tstep : cA; const char* nB = has_next ? (const char*)g.Bt + (size_t)nxt.pn * tstep : cB;
        for (int t = 0; t < nt; t += 2) {
            const bool last = (t == nt - 2);
            const char* a1 = cA + (size_t)(t + 1) * kstepA;
            const char* a2 = last ? nA : cA + (size_t)(t + 2) * kstepA; const char* b2 = last ? nB : cB + (size_t)(t + 2) * kstepB;
            const char* a3 = a2 + kstepA; const char* b3 = b2 + kstepB;
            if (last && has_next) S.a_ready(nxt);
            if constexpr (SP2) {
            PG8_LDB(B0, 0, 0); PG8_LDB(B1, 0, 1); PG8_SCHED; PG8_LDA(At, 0, 0); PG8_STAGE(PG8_SA(1, 1), a1 + hstepA, voffA);
            PG8_WAIT_V(8); PG8_WAIT_L(0); PG8_BAR; PG8_MMA(0, 0, At, B0); PG8_MMA(0, 1, At, B1); PG8_BAR; PG8_SCHED;
            PG8_LDA(At, 0, 1); PG8_STAGE(PG8_SB(0, 0), b2, voffB); PG8_STAGE(PG8_SB(0, 1), b2 + hstepB, voffB); PG8_STAGE(PG8_SA(0, 0), a2, voffA);
            PG8_WAIT_V(8); PG8_WAIT_L(0); PG8_BAR; PG8_MMA(1, 0, At, B0); PG8_MMA(1, 1, At, B1); PG8_BAR; PG8_SCHED;
            PG8_LDB(B0, 1, 0); PG8_LDB(B1, 1, 1); PG8_SCHED; PG8_LDA(At, 1, 0); PG8_STAGE(PG8_SA(0, 1), a2 + hstepA, voffA);
            PG8_WAIT_V(8); PG8_WAIT_L(0); PG8_BAR; PG8_MMA(0, 0, At, B0); PG8_MMA(0, 1, At, B1); PG8_BAR; PG8_SCHED;
            PG8_LDA(At, 1, 1); PG8_STAGE(PG8_SB(1, 0), b3, voffB); PG8_STAGE(PG8_SB(1, 1), b3 + hstepB, voffB); PG8_STAGE(PG8_SA(1, 0), a3, voffA);
            PG8_WAIT_V(8); PG8_WAIT_L(0); PG8_BAR; PG8_MMA(1, 0, At, B0); PG8_MMA(1, 1, At, B1); PG8_BAR; PG8_SCHED;
            } else {
            PG8_LDB(B0, 0, 0); PG8_SCHED; PG8_LDA(At, 0, 0); PG8_STAGE(PG8_SA(1, 1), a1 + hstepA, voffA);
            PG8_WAIT_L(8); PG8_BAR; PG8_WAIT_L(0); PG8_MMA(0, 0, At, B0); PG8_BAR; PG8_SCHED;
            PG8_LDB(B1, 0, 1); PG8_STAGE(PG8_SB(0, 0), b2, voffB);
            PG8_BAR; PG8_WAIT_L(0); PG8_MMA(0, 1, At, B1); PG8_BAR;
            PG8_LDA(At, 0, 1); PG8_STAGE(PG8_SA(0, 0), a2, voffA);
            PG8_BAR; PG8_WAIT_L(0); PG8_MMA(1, 0, At, B0); PG8_BAR; PG8_SCHED;
            PG8_STAGE(PG8_SB(0, 1), b2 + hstepB, voffB);
            PG8_WAIT_V(6); PG8_BAR; PG8_MMA(1, 1, At, B1); PG8_BAR;
            PG8_LDB(B0, 1, 0); PG8_SCHED; PG8_LDA(At, 1, 0); PG8_STAGE(PG8_SA(0, 1), a2 + hstepA, voffA);
            PG8_WAIT_L(8); PG8_BAR; PG8_WAIT_L(0); PG8_MMA(0, 0, At, B0); PG8_BAR; PG8_SCHED;
            PG8_LDB(B1, 1, 1); PG8_STAGE(PG8_SB(1, 0), b3, voffB);
            PG8_BAR; PG8_WAIT_L(0); PG8_MMA(0, 1, At, B1); PG8_BAR;
            PG8_LDA(At, 1, 1); PG8_STAGE(PG8_SA(1, 0), a3, voffA);
            PG8_BAR; PG8_WAIT_L(0); PG8_MMA(1, 0, At, B0); PG8_BAR; PG8_SCHED;
            PG8_STAGE(PG8_SB(1, 1), b3 + hstepB, voffB);
            PG8_WAIT_V(6); PG8_BAR; PG8_MMA(1, 1, At, B1); PG8_BAR;
            }
        }
        if constexpr (ALIGN_EPI) { if (wr == 0) PG8_BAR; }
        if constexpr (!Epi::AFTER_DRAIN) { E(acc, cur, wr, wc, fr, fq, rs_area); S.done(cur); }
        if (!has_next) break;
#pragma unroll
        for (int a = 0; a < 2; ++a)
#pragma unroll
            for (int b = 0; b < 2; ++b)
#pragma unroll
                for (int m = 0; m < 4; ++m)
#pragma unroll
                    for (int n = 0; n < 2; ++n) acc[a][b][m][n] = (f32x4){0.f, 0.f, 0.f, 0.f};
        cur = nxt; cA = nA; cB = nB; ++ui;
        if constexpr (ALIGN_EPI) { if (wr == 1) PG8_BAR; }
    }
    PG8_WAIT_V(0);
    if constexpr (!ALIGN_EPI) { if (wr == 0) PG8_BAR; }
    PG8_BAR;
    if constexpr (Epi::AFTER_DRAIN) { E.fused(acc, cur, wr, wc, fr, fq, lds, wid, lane); S.done(cur); }
#undef PG8_SA
#undef PG8_SB
#undef PG8_STAGE
#undef PG8_LDA
#undef PG8_LDB
#undef PG8_MMA
#undef PG8_WAIT_V
#undef PG8_WAIT_L
#undef PG8_BAR
#undef PG8_SCHED
}
}

#define LAS __attribute__((address_space(3)))
using pg8::bf16_t; using pg8::bf16x8; using pg8::f32x4; using pg8::u32x4;
typedef unsigned u32x2 __attribute__((ext_vector_type(2)));

constexpr int BATCH = 4, SEQ = 8192, DM = 2048, DFF = 5632, M = BATCH * SEQ, NCH = SEQ / 64, DEPTH = 4;
constexpr int EV_N = 5136, EV_NP = 5376, OD_N = 3072;
constexpr float EPS = 1e-6f;
constexpr int NTHREADS = 512, NWAVES = 8, LDS_BYTES = 147456;
#ifndef WGM_FFN1
#define WGM_FFN1 4
#endif
#ifndef WGM_FFN2
#define WGM_FFN2 4
#endif
#ifndef WGM_MIN
#define WGM_MIN 4
#endif
#ifndef WGM_MOUT
#define WGM_MOUT 4
#endif
#ifndef FFN_SPLIT
#define FFN_SPLIT 1
#endif

constexpr size_t MiB = (size_t)1 << 20;
constexpr size_t WS_CTL = 0;
constexpr size_t WS_W1A = 1 * MiB;
constexpr size_t WS_W1B = 45 * MiB;
constexpr size_t WS_W2A = 89 * MiB;
constexpr size_t WS_W2B = 111 * MiB;
constexpr size_t WS_WIN = 133 * MiB;
constexpr size_t WS_WOUT = 154 * MiB;
constexpr size_t WS_WAT = 162 * MiB;
constexpr size_t WS_WXT = WS_WAT + 262144;
constexpr size_t WS_POOLT = WS_WAT + 524288;
constexpr size_t WS_U = 163 * MiB;
constexpr size_t WS_HB = 291 * MiB;
constexpr size_t WS_HO = 643 * MiB;
constexpr size_t WS_MX = WS_HO;
constexpr size_t WS_S = 1290 * MiB;
constexpr size_t WS_XB = 1306 * MiB;
constexpr size_t WS_RS = 1434 * MiB;
constexpr size_t WS_END = 1435 * MiB;
constexpr size_t WS_UG = WS_MX, WS_SS = WS_MX + 256 * MiB, WS_BC = WS_MX + 384 * MiB, WS_HLOC = WS_MX + 448 * MiB, WS_APROD = WS_MX + 512 * MiB;
constexpr size_t WS_UM = WS_MX, WS_CS = WS_MX + 256 * MiB, WS_XC = WS_MX + 512 * MiB, WS_Q = WS_MX + 576 * MiB;
constexpr size_t WS_V = WS_HB + 192 * MiB, WS_KB = WS_HB + 256 * MiB;
constexpr size_t WS_CARA = WS_S, WS_CARH = WS_S + 2 * MiB, WS_DEC = WS_S + 4 * MiB, WS_GATES = WS_S + 5 * MiB, WS_SC = WS_S + 6 * MiB, WS_MS = WS_S + 7 * MiB, WS_NU = WS_S + 8 * MiB, WS_NS = WS_S + 10 * MiB;

enum { I_X = 0, I_NORMG, I_WG, I_WU, I_WD, I_EVIN, I_EVOUT, I_LCW, I_LCB, I_LWA, I_LBA, I_LWX, I_LBX, I_LLAM, I_GWG, I_GBG, I_GNORM,
       I_ODIN, I_ODOUT, I_MCW, I_MCB, I_MWQ, I_MWK, I_MWV, I_MWIF, I_MBIF, I_MSKIP, I_MNORM, I_POOLW, I_POOLS };

struct KP { const float* in[30]; float* out; unsigned char* ws; };
#define GP(T, off) ((T*)(p.ws + (off)))

__device__ __forceinline__ float bf2f(bf16_t b) { return __uint_as_float(((unsigned)b) << 16); }
__device__ __forceinline__ float bflo(unsigned w) { return __uint_as_float(w << 16); }
__device__ __forceinline__ float bfhi(unsigned w) { return __uint_as_float(w & 0xffff0000u); }
__device__ __forceinline__ bf16_t f2bf(float f) { unsigned u = __float_as_uint(f); u += 0x7fffu + ((u >> 16) & 1u); return (bf16_t)(u >> 16); }
__device__ __forceinline__ unsigned pk2(float lo, float hi) { return (unsigned)f2bf(lo) | ((unsigned)f2bf(hi) << 16); }
__device__ __forceinline__ float wave_sum(float v) {
#pragma unroll
    for (int o = 1; o < 64; o <<= 1) v += __shfl_xor(v, o);
    return v;
}
__device__ __forceinline__ float wave_max(float v) {
#pragma unroll
    for (int o = 1; o < 64; o <<= 1) v = fmaxf(v, __shfl_xor(v, o));
    return v;
}
__device__ __forceinline__ float sigmoid_f(float x) { return 1.0f / (1.0f + __expf(-x)); }
__device__ __forceinline__ float logsigmoid_f(float x) { return fminf(x, 0.0f) - __logf(1.0f + __expf(-fabsf(x))); }
__device__ __forceinline__ float one_minus_exp_f(float x) { const float ser = -x * (1.0f + x * (0.5f + x * (0.16666667f + x * (0.041666668f + x * 0.008333334f)))); return x > -0.25f ? ser : 1.0f - __expf(x); }
__device__ __forceinline__ float gelu_tanh_f(float x) { const float y = 0.7978845608028654f * (x + 0.044715f * x * x * x); const float t = 1.0f - 2.0f / (__expf(2.0f * y) + 1.0f); return 0.5f * x * (1.0f + t); }
#define MFMA16(a, b, c) __builtin_amdgcn_mfma_f32_16x16x32_bf16((a), (b), (c), 0, 0, 0)
__device__ __forceinline__ bf16x8 lds_frag(const LAS bf16_t* base, int ld, int r0, int k0, int lane) { return *(const LAS bf16x8*)(base + (r0 + (lane & 15)) * ld + k0 + (lane >> 4) * 8); }
__device__ __forceinline__ bf16x8 glb_frag(const bf16_t* base, int ld, int r0, int k0, int lane) { return *(const bf16x8*)(base + (size_t)(r0 + (lane & 15)) * ld + k0 + (lane >> 4) * 8); }
#define F4ZERO ((f32x4){0.f, 0.f, 0.f, 0.f})
typedef short s16x4 __attribute__((ext_vector_type(4)));
__device__ __forceinline__ bf16x8 tr_frag(const LAS bf16_t* base, int ld, int kA, int kB, int n0, int lane) {
    const int q = (lane >> 2) & 3, pp = lane & 3;
    const s16x4 lo = __builtin_amdgcn_ds_read_tr16_b64_v4i16((LAS s16x4*)(base + (kA + q) * ld + n0 + 4 * pp));
    const s16x4 hi = __builtin_amdgcn_ds_read_tr16_b64_v4i16((LAS s16x4*)(base + (kB + q) * ld + n0 + 4 * pp));
    return __builtin_shufflevector(lo, hi, 0, 1, 2, 3, 4, 5, 6, 7);
}
__device__ __forceinline__ bf16x8 lds_frag_perm(const LAS bf16_t* base, int ld, int r0, int k0, int lane) {
    const LAS bf16_t* pr = base + (r0 + (lane & 15)) * ld + k0 + 4 * (lane >> 4);
    const s16x4 lo = *(const LAS s16x4*)pr, hi = *(const LAS s16x4*)(pr + 16);
    return __builtin_shufflevector(lo, hi, 0, 1, 2, 3, 4, 5, 6, 7);
}

struct WItem { const float* W; bf16_t* WT; const float* gk; int K, N, k0, n0, drow0; bool big; };
__device__ __forceinline__ WItem w_item(const KP& p, int l, int it) {
    const int j = l >> 1; const bool even = (l & 1) == 0;
    constexpr int FI = (DM / 64) * (DFF / 64);
    const int n_in = even ? (DM / 64) * ((EV_N + 63) / 64) : (DM / 64) * (OD_N / 64), n_out = (DM / 64) * (DM / 64);
    WItem w; w.gk = nullptr; w.big = true; int mode = 0, r;
    if (it < 6 * FI) { const int mtx = it / FI; r = it % FI; const int s = mtx / 3, kind = mtx % 3; const size_t wo = (size_t)(l * 2 + s) * DM * DFF;
        if (kind == 0) { w.W = p.in[I_WG] + wo; w.K = DM; w.N = DFF; w.WT = GP(bf16_t, s ? WS_W1B : WS_W1A); mode = 1; w.gk = p.in[I_NORMG] + (size_t)(l * 6 + (s ? 4 : 0)) * DM; }
        else if (kind == 1) { w.W = p.in[I_WU] + wo; w.K = DM; w.N = DFF; w.WT = GP(bf16_t, s ? WS_W1B : WS_W1A); mode = 2; w.gk = p.in[I_NORMG] + (size_t)(l * 6 + (s ? 4 : 0)) * DM; }
        else { w.W = p.in[I_WD] + wo; w.K = DFF; w.N = DM; w.WT = GP(bf16_t, s ? WS_W2B : WS_W2A); } }
    else { r = it - 6 * FI;
        if (r < n_in) { w.K = DM; w.WT = GP(bf16_t, WS_WIN); w.gk = p.in[I_NORMG] + (size_t)(l * 6 + 2) * DM; if (even) { w.W = p.in[I_EVIN] + (size_t)j * DM * EV_N; w.N = EV_N; } else { w.W = p.in[I_ODIN] + (size_t)j * DM * OD_N; w.N = OD_N; } }
        else if (r < n_in + n_out) { r -= n_in; w.K = DM; w.N = DM; w.WT = GP(bf16_t, WS_WOUT); w.W = (even ? p.in[I_EVOUT] : p.in[I_ODOUT]) + (size_t)j * DM * DM; }
        else { r -= n_in + n_out; w.big = false;
            if (even) { const int mi = r >> 2; r &= 3; w.K = 128; w.N = 128; const int hd = mi & 7; w.W = (mi < 8 ? p.in[I_LWA] : p.in[I_LWX]) + (size_t)(j * 8 + hd) * 16384; w.WT = GP(bf16_t, mi < 8 ? WS_WAT : WS_WXT) + hd * 16384; }
            else { const int g = r >> 4; r &= 15; w.K = 256; w.N = 256; w.W = p.in[I_POOLW] + (size_t)(j * 4 + g) * 65536; w.WT = GP(bf16_t, WS_POOLT) + g * 65536; } } }
    const int nkb = w.K >> 6, nbi = r / nkb, kb = r % nkb;
    w.n0 = nbi * 64; w.k0 = kb * 64; w.drow0 = mode == 0 ? w.n0 : ((w.n0 >> 7) * 256 + (w.n0 & 127) + (mode == 2 ? 128 : 0));
    return w;
}
__device__ __forceinline__ void tr_load(const WItem& w, f32x4 (&v)[16], float& gl, int lane) {
    const int r4 = lane >> 4, c16 = lane & 15, nl = w.n0 + 4 * c16; const bool ok = nl < w.N;
    gl = w.gk ? w.gk[w.k0 + lane] : 1.0f;
    const float* src = w.W + (size_t)(w.k0 + r4) * w.N + nl; const size_t step = (size_t)4 * w.N;
#pragma unroll
    for (int i = 0; i < 16; ++i) { v[i] = ok ? __builtin_nontemporal_load((const f32x4*)src) : F4ZERO; src += step; asm volatile("" : "+v"(src)); }
}
__device__ __forceinline__ void tr_store(const WItem& w, const f32x4 (&v)[16], float gl, LAS float* scr, int lane) {
    const int r4 = lane >> 4, c16 = lane & 15;
#pragma unroll
    for (int i = 0; i < 16; ++i) { const float gg = __shfl(gl, 4 * i + r4); LAS float* d = scr + (4 * i + r4) * 65 + 4 * c16; d[0] = v[i][0] * gg; d[1] = v[i][1] * gg; d[2] = v[i][2] * gg; d[3] = v[i][3] * gg; }
    asm volatile("s_waitcnt lgkmcnt(0)" ::: "memory");
    const int c = lane & 7;
#pragma unroll
    for (int jj = 0; jj < 8; ++jj) { const int nn = (lane >> 3) + 8 * jj; const LAS float* s = scr + (8 * c) * 65 + nn;
        u32x4 o; o.x = pk2(s[0 * 65], s[1 * 65]); o.y = pk2(s[2 * 65], s[3 * 65]); o.z = pk2(s[4 * 65], s[5 * 65]); o.w = pk2(s[6 * 65], s[7 * 65]);
        if (w.n0 + nn < w.N) { const int dr = w.drow0 + nn; bf16_t* dst = w.big ? w.WT + ((((size_t)(dr >> 8) * (w.K >> 6) + (w.k0 >> 6)) * 256 + (dr & 255)) << 6) + 8 * c : w.WT + (size_t)dr * w.K + w.k0 + 8 * c; asm volatile("global_store_dwordx4 %0, %1, off sc1\n\ts_nop 1" :: "v"(dst), "v"(o) : "memory"); } }
    asm volatile("s_waitcnt lgkmcnt(0)" ::: "memory");
}
__device__ __forceinline__ void ph_weights(const KP& p, int l, LAS unsigned char* lds) {
    const int tid = otid(), lane = tid & 63, wave = tid >> 6;
    LAS float* scr = (LAS float*)(lds + wave * 16640);
    const int gw = obid() * NWAVES + wave, NGW = gridDim.x * NWAVES;
    const bool even = (l & 1) == 0;
    constexpr int FI = (DM / 64) * (DFF / 64);
    const int n_in = even ? (DM / 64) * ((EV_N + 63) / 64) : (DM / 64) * (OD_N / 64), n_out = (DM / 64) * (DM / 64);
    const int total = 6 * FI + n_in + n_out + 64;
    f32x4 v[16]; float gl = 1.0f;
    if (gw < total) { const WItem w0 = w_item(p, l, gw); tr_load(w0, v, gl, lane); }
    for (int it = gw; it < total; it += NGW) {
        const int itn = it + NGW; f32x4 vn[16]; float gln = 1.0f;
        if (itn < total) { const WItem wn = w_item(p, l, itn); tr_load(wn, vn, gln, lane); }
        { const WItem wc = w_item(p, l, it); tr_store(wc, v, gl, scr, lane); }
        gl = gln;
#pragma unroll
        for (int i = 0; i < 16; ++i) v[i] = vn[i];
    }
    if (even) {
        bf16_t* pz = GP(bf16_t, WS_WIN) + (size_t)(EV_N >> 8) * DM * 256; constexpr int per_kt = (256 - (EV_N & 255)) * 64 * 2 / 16;
        for (int i = obid() * NTHREADS + tid; i < (DM / 64) * per_kt; i += gridDim.x * NTHREADS) { const int kt = i / per_kt, o = i % per_kt; ((u32x4*)(pz + ((size_t)kt * 256 + (EV_N & 255)) * 64))[o] = (u32x4){0u, 0u, 0u, 0u}; }
    }
}

constexpr int Q_FI = (DM / 64) * (DFF / 64), Q_NOUT = (DM / 64) * (DM / 64), CW_QCTR = 8192;
__device__ __forceinline__ int q_nin(int l) { return (l & 1) ? (DM / 64) * (OD_N / 64) : (DM / 64) * ((EV_N + 63) / 64); }
__device__ __forceinline__ int q_total(int l, int part) { return part == 0 ? 3 * Q_FI + q_nin(l) + 64 : 3 * Q_FI + Q_NOUT; }
__device__ __forceinline__ int q_map(int l, int part, int q) {
    const int nin = q_nin(l);
    if (part == 0) return q < 3 * Q_FI ? q : (q < 3 * Q_FI + nin ? 6 * Q_FI + (q - 3 * Q_FI) : 6 * Q_FI + nin + Q_NOUT + (q - 3 * Q_FI - nin));
    return q < 3 * Q_FI ? 3 * Q_FI + q : 6 * Q_FI + nin + (q - 3 * Q_FI);
}
__device__ __forceinline__ bool fill_step(const KP& p, int l, int part, LAS unsigned char* lds) {
    if (l < 0 || l >= DEPTH) return false;
    const int tid = otid(), lane = tid & 63, wave = __builtin_amdgcn_readfirstlane(tid >> 6);
    LAS float* scr = (LAS float*)(lds + wave * 16640);
    const int total = q_total(l, part), home = (obid() + wave) & 7;
    unsigned* ctr0 = (unsigned*)(p.ws + WS_CTL) + CW_QCTR + (size_t)((l * 2 + part) * 8) * 64;
    for (int k = 0; k < 8; ++k) { const int sh = (home + k) & 7, cnt = (total - sh + 7) >> 3; unsigned* ctr = ctr0 + sh * 64;
        if ((int)__builtin_amdgcn_readfirstlane(__hip_atomic_load(ctr, __ATOMIC_RELAXED, __HIP_MEMORY_SCOPE_AGENT)) >= cnt) continue;
        unsigned jq = 0u; if (lane == 0) jq = __hip_atomic_fetch_add(ctr, 1u, __ATOMIC_RELAXED, __HIP_MEMORY_SCOPE_AGENT);
        jq = (unsigned)__builtin_amdgcn_readfirstlane((int)jq);
        if ((int)jq >= cnt) continue;
        const WItem w = w_item(p, l, q_map(l, part, (int)jq * 8 + sh)); f32x4 v[16]; float gl; tr_load(w, v, gl, lane); tr_store(w, v, gl, scr, lane);
        return true; }
    return false;
}
__device__ __forceinline__ void ph_weights_drain(const KP& p, int l, int part, LAS unsigned char* lds) {
    while (fill_step(p, l, part, lds)) {}
    if (part == 0 && (l & 1) == 0) {
        const int tid = otid(); bf16_t* pz = GP(bf16_t, WS_WIN) + (size_t)(EV_N >> 8) * DM * 256; constexpr int per_kt = (256 - (EV_N & 255)) * 64 * 2 / 16;
        for (int i = obid() * NTHREADS + tid; i < (DM / 64) * per_kt; i += gridDim.x * NTHREADS) { const int kt = i / per_kt, o = i % per_kt; ((u32x4*)(pz + ((size_t)kt * 256 + (EV_N & 255)) * 64))[o] = (u32x4){0u, 0u, 0u, 0u}; }
    }
}
__device__ __forceinline__ void ph_weights_part(const KP& p, int l, int part, LAS unsigned char* lds) {
    const int tid = otid(), lane = tid & 63, wave = tid >> 6;
    LAS float* scr = (LAS float*)(lds + wave * 16640);
    const int gw = obid() * NWAVES + wave, NGW = gridDim.x * NWAVES, total = q_total(l, part);
    for (int q = gw; q < total; q += NGW) { const WItem w = w_item(p, l, q_map(l, part, q)); f32x4 v[16]; float gl; tr_load(w, v, gl, lane); tr_store(w, v, gl, scr, lane); }
    if (part == 0 && (l & 1) == 0) {
        bf16_t* pz = GP(bf16_t, WS_WIN) + (size_t)(EV_N >> 8) * DM * 256; constexpr int per_kt = (256 - (EV_N & 255)) * 64 * 2 / 16;
        for (int i = obid() * NTHREADS + tid; i < (DM / 64) * per_kt; i += gridDim.x * NTHREADS) { const int kt = i / per_kt, o = i % per_kt; ((u32x4*)(pz + ((size_t)kt * 256 + (EV_N & 255)) * 64))[o] = (u32x4){0u, 0u, 0u, 0u}; }
    }
}

#define XB_OFF(r, lane) ((((size_t)((r) >> 8) * 32 + ((lane) >> 3)) * 256 + ((r) & 255)) * 64 + 8 * ((lane) & 7))
#define XB_JSTEP (8 * 256 * 64 / 8)
__device__ __forceinline__ size_t mix_off(int r, int c) { return ((((size_t)(r >> 8) * 32 + (c >> 6)) * 256 + (r & 255)) << 6) + (c & 63); }
__device__ __forceinline__ void ph_norm0(const float* xin, bf16_t* xb, float* rsq) {
    const int tid = otid(), lane = tid & 63, wave = tid >> 6;
    const int gw = obid() * NWAVES + wave, NGW = gridDim.x * NWAVES;
    f32x4 vn[8];
    if (gw < M) { const f32x4* xr = (const f32x4*)(xin + (size_t)gw * DM) + 2 * lane;
#pragma unroll
        for (int jx = 0; jx < 4; ++jx) { vn[2 * jx] = __builtin_nontemporal_load(xr + 128 * jx); vn[2 * jx + 1] = __builtin_nontemporal_load(xr + 128 * jx + 1); } }
    for (int row = gw; row < M; row += NGW) {
        f32x4 v[8]; float ss = 0.f;
#pragma unroll
        for (int jx = 0; jx < 8; ++jx) v[jx] = vn[jx];
        const int nrow = row + NGW;
        if (nrow < M) { const f32x4* xr = (const f32x4*)(xin + (size_t)nrow * DM) + 2 * lane;
#pragma unroll
            for (int jx = 0; jx < 4; ++jx) { vn[2 * jx] = __builtin_nontemporal_load(xr + 128 * jx); vn[2 * jx + 1] = __builtin_nontemporal_load(xr + 128 * jx + 1); } }
#pragma unroll
        for (int jx = 0; jx < 8; ++jx) ss += (v[jx][0] * v[jx][0] + v[jx][1] * v[jx][1]) + (v[jx][2] * v[jx][2] + v[jx][3] * v[jx][3]);
        ss = wave_sum(ss); if (lane == 0) rsq[row] = rsqrtf(ss * (1.0f / DM) + EPS);
        u32x4* xo = (u32x4*)(xb + XB_OFF(row, lane));
#pragma unroll
        for (int jx = 0; jx < 4; ++jx) { const f32x4 a = v[2 * jx], c = v[2 * jx + 1]; xo[XB_JSTEP * jx] = (u32x4){pk2(a[0], a[1]), pk2(a[2], a[3]), pk2(c[0], c[1]), pk2(c[2], c[3])}; }
    }
}
__device__ __forceinline__ void ph_norm(const bf16_t* xin, const bf16_t* h, float scale, const float* ga, bf16_t* xout16, float* xout32, float* rsq) {
    const int tid = otid(), lane = tid & 63, wave = tid >> 6;
    const int gw = obid() * NWAVES + wave, NGW = gridDim.x * NWAVES;
    u32x4 xn[4], hn[4];
    if (gw < M) { const u32x4* xr = (const u32x4*)(xin + XB_OFF(gw, lane)); const u32x4* hr = (const u32x4*)(h + (size_t)gw * DM) + lane;
#pragma unroll
        for (int jx = 0; jx < 4; ++jx) { xn[jx] = xr[XB_JSTEP * jx]; hn[jx] = __builtin_nontemporal_load(hr + 64 * jx); } }
    for (int row = gw; row < M; row += NGW) {
        u32x4 xw[4], hw[4];
#pragma unroll
        for (int jx = 0; jx < 4; ++jx) { xw[jx] = xn[jx]; hw[jx] = hn[jx]; }
        const int nrow = row + NGW;
        if (nrow < M) { const u32x4* xr = (const u32x4*)(xin + XB_OFF(nrow, lane)); const u32x4* hr = (const u32x4*)(h + (size_t)nrow * DM) + lane;
#pragma unroll
            for (int jx = 0; jx < 4; ++jx) { xn[jx] = xr[XB_JSTEP * jx]; hn[jx] = __builtin_nontemporal_load(hr + 64 * jx); } }
        float hv[32]; float ss = 0.f;
#pragma unroll
        for (int jx = 0; jx < 4; ++jx) { const unsigned w4[4] = {hw[jx].x, hw[jx].y, hw[jx].z, hw[jx].w};
#pragma unroll
            for (int e = 0; e < 4; ++e) { const float a = bflo(w4[e]), c = bfhi(w4[e]); hv[8 * jx + 2 * e] = a; hv[8 * jx + 2 * e + 1] = c; ss += a * a + c * c; } }
        ss = wave_sum(ss); const float rsh = rsqrtf(ss * (1.0f / DM) + EPS) * scale;
        float xv[32]; float s2 = 0.f;
#pragma unroll
        for (int jx = 0; jx < 4; ++jx) { const unsigned w4[4] = {xw[jx].x, xw[jx].y, xw[jx].z, xw[jx].w}; const f32x4 g0 = ((const f32x4*)ga)[128 * jx + 2 * lane], g1 = ((const f32x4*)ga)[128 * jx + 2 * lane + 1];
            const float g8[8] = {g0[0], g0[1], g0[2], g0[3], g1[0], g1[1], g1[2], g1[3]};
#pragma unroll
            for (int e = 0; e < 4; ++e) { const float a = bflo(w4[e]) + hv[8 * jx + 2 * e] * g8[2 * e] * rsh, c = bfhi(w4[e]) + hv[8 * jx + 2 * e + 1] * g8[2 * e + 1] * rsh; xv[8 * jx + 2 * e] = a; xv[8 * jx + 2 * e + 1] = c; s2 += a * a + c * c; } }
        s2 = wave_sum(s2); if (lane == 0) rsq[row] = rsqrtf(s2 * (1.0f / DM) + EPS);
        if (xout16) { u32x4* xo = (u32x4*)(xout16 + XB_OFF(row, lane));
#pragma unroll
            for (int jx = 0; jx < 4; ++jx) xo[XB_JSTEP * jx] = (u32x4){pk2(xv[8 * jx], xv[8 * jx + 1]), pk2(xv[8 * jx + 2], xv[8 * jx + 3]), pk2(xv[8 * jx + 4], xv[8 * jx + 5]), pk2(xv[8 * jx + 6], xv[8 * jx + 7])}; }
        if (xout32) { f32x4* xo = (f32x4*)(xout32 + (size_t)row * DM) + 2 * lane;
#pragma unroll
            for (int jx = 0; jx < 4; ++jx) { xo[128 * jx] = (f32x4){xv[8 * jx], xv[8 * jx + 1], xv[8 * jx + 2], xv[8 * jx + 3]}; xo[128 * jx + 1] = (f32x4){xv[8 * jx + 4], xv[8 * jx + 5], xv[8 * jx + 6], xv[8 * jx + 7]}; } }
    }
}

struct LruC { bf16x8 fa[4], fx[4]; float w0, w1, w2, w3, cb, ba, bx, sp; };
struct LruPre { u32x4 rv[3]; };
__device__ __forceinline__ void lru_local_consts(const KP& p, LruC& C, int j, int hd, int tid) {
    const int lane = tid & 63, wave = tid >> 6, c0 = hd * 128, ccq = c0 + (tid & 127), cj = c0 + wave * 16 + (lane & 15);
    const bf16_t* waT = GP(const bf16_t, WS_WAT) + (size_t)hd * 16384; const bf16_t* wxT = GP(const bf16_t, WS_WXT) + (size_t)hd * 16384;
#pragma unroll
    for (int ks = 0; ks < 4; ++ks) { C.fa[ks] = glb_frag(waT, 128, wave * 16, ks * 32, lane); C.fx[ks] = glb_frag(wxT, 128, wave * 16, ks * 32, lane); }
    const float* cw = p.in[I_LCW] + (size_t)j * 4096; C.w0 = cw[ccq]; C.w1 = cw[1024 + ccq]; C.w2 = cw[2048 + ccq]; C.w3 = cw[3072 + ccq]; C.cb = p.in[I_LCB][j * 1024 + ccq];
    C.ba = p.in[I_LBA][j * 1024 + cj]; C.bx = p.in[I_LBX][j * 1024 + cj]; C.sp = log1pf(__expf(-p.in[I_LLAM][j * 1024 + cj]));
#pragma unroll
    for (int ks = 0; ks < 4; ++ks) { asm volatile("" : "+v"(C.fa[ks])); asm volatile("" : "+v"(C.fx[ks])); }
    asm volatile("" : "+v"(C.w0), "+v"(C.w1), "+v"(C.w2), "+v"(C.w3), "+v"(C.cb), "+v"(C.ba), "+v"(C.bx), "+v"(C.sp));
}
__device__ __forceinline__ void lru_local_load(const KP& p, LruPre& P, int b, int n, int hd, int tid) {
    const bf16_t* Z = GP(const bf16_t, WS_HB); const int row0 = b * SEQ + n * 64, c0 = hd * 128;
#pragma unroll
    for (int k = 0; k < 3; ++k) { const int idx = tid + NTHREADS * k, rr = idx >> 4, sg = idx & 15; P.rv[k] = (u32x4){0u, 0u, 0u, 0u};
        if (idx < 67 * 16 && n * 64 + rr - 3 >= 0) P.rv[k] = *(const u32x4*)(Z + (size_t)(row0 + rr - 3) * EV_NP + c0 + sg * 8); }
}
__device__ __forceinline__ void lru_local_unit(const KP& p, const LruC& C, int b, int n, int hd, LAS unsigned char* lds, LruPre& pre, bool has_next, int b2, int n2, int hd2) {
    const int tid = otid(), lane = tid & 63, wave = __builtin_amdgcn_readfirstlane(tid >> 6);
    LAS bf16_t* A = (LAS bf16_t*)lds;
    LAS bf16_t* Rw = (LAS bf16_t*)(lds + 17408);
    LAS float* LA = (LAS float*)(lds + 35840); LAS float* BI = (LAS float*)(lds + 69632); LAS float* SEG = (LAS float*)(lds + 103424);
    const int row0 = b * SEQ + n * 64, c0 = hd * 128;
    const int cq = tid & 127, q = tid >> 7, ccq = c0 + cq;
    const float w0 = C.w0, w1 = C.w1, w2 = C.w2, w3 = C.w3, cb = C.cb;
    const int jj = wave * 16 + (lane & 15);
    const float ba = C.ba, bx = C.bx;
#pragma unroll
    for (int k = 0; k < 3; ++k) { const int idx = tid + NTHREADS * k, rr = idx >> 4, sg = idx & 15; if (idx < 67 * 16) *(LAS u32x4*)(Rw + rr * 136 + sg * 8) = pre.rv[k]; }
    if (has_next) lru_local_load(p, pre, b2, n2, hd2, tid);
    __syncthreads();
    { const int t0 = q * 16; float x3 = bf2f(Rw[t0 * 136 + cq]), x2 = bf2f(Rw[(t0 + 1) * 136 + cq]), x1 = bf2f(Rw[(t0 + 2) * 136 + cq]);
#pragma unroll
      for (int i = 0; i < 16; ++i) { const int t = t0 + i; const float xv = bf2f(Rw[(t + 3) * 136 + cq]); A[t * 136 + cq] = f2bf(w0 * x3 + w1 * x2 + w2 * x1 + w3 * xv + cb); x3 = x2; x2 = x1; x1 = xv; } }
    __syncthreads();
    { f32x4 aa[4], ax[4];
#pragma unroll
      for (int tt = 0; tt < 4; ++tt) { aa[tt] = F4ZERO; ax[tt] = F4ZERO; }
#pragma unroll
      for (int ks = 0; ks < 4; ++ks)
#pragma unroll
          for (int tt = 0; tt < 4; ++tt) { const bf16x8 af = lds_frag(A, 136, tt * 16, ks * 32, lane); aa[tt] = MFMA16(af, C.fa[ks], aa[tt]); ax[tt] = MFMA16(af, C.fx[ks], ax[tt]); }
      const float sp = C.sp;
#pragma unroll
      for (int tt = 0; tt < 4; ++tt)
#pragma unroll
          for (int i = 0; i < 4; ++i) { const int t = tt * 16 + (lane >> 4) * 4 + i; const float r = sigmoid_f(aa[tt][i] + ba), ig = sigmoid_f(ax[tt][i] + bx);
              const float la = -8.0f * r * sp, xcv = bf2f(A[t * 136 + jj]); LA[t * 132 + jj] = la; BI[t * 132 + jj] = sqrtf(one_minus_exp_f(2.0f * la)) * ig * xcv; } }
    __syncthreads();
    { const int t0 = q * 16; float cs = 0.f, h = 0.f; float hs[16], cc_[16];
#pragma unroll
      for (int i = 0; i < 16; ++i) { const float la = LA[(t0 + i) * 132 + cq]; cs += la; h = __expf(la) * h + BI[(t0 + i) * 132 + cq]; hs[i] = h; cc_[i] = cs; }
      SEG[(q * 128 + cq) * 2] = cs; SEG[(q * 128 + cq) * 2 + 1] = h;
      __syncthreads();
      float Hs = 0.f, Cs = 0.f;
      for (int q2 = 0; q2 < q; ++q2) { const float a = SEG[(q2 * 128 + cq) * 2], hh = SEG[(q2 * 128 + cq) * 2 + 1]; Hs = __expf(a) * Hs + hh; Cs += a; }
#pragma unroll
      for (int i = 0; i < 16; ++i) { const int t = t0 + i; A[t * 136 + cq] = f2bf(hs[i] + __expf(cc_[i]) * Hs); Rw[t * 136 + cq] = f2bf(__expf(cc_[i] + Cs)); }
      if (q == 3) { const size_t ci = (size_t)(b * NCH + n) * 1024 + ccq; GP(float, WS_CARA)[ci] = __expf(cc_[15] + Cs); GP(float, WS_CARH)[ci] = hs[15] + __expf(cc_[15]) * Hs; } }
    __syncthreads();
    { const int t = tid >> 3, sg = tid & 7; const LAS u32x4* sh = (const LAS u32x4*)(A + t * 136 + sg * 16); const LAS u32x4* sa = (const LAS u32x4*)(Rw + t * 136 + sg * 16);
      u32x4* dh = (u32x4*)(GP(bf16_t, WS_HLOC) + (size_t)(row0 + t) * 1024 + c0 + sg * 16); u32x4* da = (u32x4*)(GP(bf16_t, WS_APROD) + (size_t)(row0 + t) * 1024 + c0 + sg * 16);
      dh[0] = sh[0]; dh[1] = sh[1]; da[0] = sa[0]; da[1] = sa[1]; }
    __syncthreads();
}

struct GlaUC { float gu[16], gb; };
struct GlaUPre { u32x4 k[2], v[4], g; };
__device__ __forceinline__ void gla_u_consts(const KP& p, GlaUC& C, int j, int h, int tid) {
#pragma unroll
    for (int r = 0; r < 16; ++r) C.gu[r] = p.in[I_GWG][(size_t)(j * 16 + r) * 512 + h * 128 + (tid & 127)];
    C.gb = p.in[I_GBG][j * 512 + h * 128 + (tid & 127)];
#pragma unroll
    for (int r = 0; r < 16; ++r) asm volatile("" : "+v"(C.gu[r]));
    asm volatile("" : "+v"(C.gb));
}
__device__ __forceinline__ void gla_u_load(const KP& p, GlaUPre& P, int b, int n, int h, int tid) {
    const bf16_t* Z = GP(const bf16_t, WS_HB); const int row0 = b * SEQ + n * 64;
    const int t = tid >> 3, sg = tid & 7; const bf16_t* zr = Z + (size_t)(row0 + t) * EV_NP;
    const u32x4* sk = (const u32x4*)(zr + 2560 + h * 128 + sg * 16); const u32x4* sv = (const u32x4*)(zr + 3072 + h * 256 + sg * 32);
    P.k[0] = sk[0]; P.k[1] = sk[1]; P.v[0] = sv[0]; P.v[1] = sv[1]; P.v[2] = sv[2]; P.v[3] = sv[3];
    if (tid < 128) { const int t2 = tid >> 1, half = tid & 1; P.g = *(const u32x4*)(Z + (size_t)(row0 + t2) * EV_NP + 5120 + half * 8); }
}
__device__ __forceinline__ void gla_u_unit(const KP& p, const GlaUC& C, int b, int n, int h, LAS unsigned char* lds, GlaUPre& pre, bool has_next, int b2, int n2, int h2) {
    const int tid = otid(), lane = tid & 63, wave = __builtin_amdgcn_readfirstlane(tid >> 6), g4 = lane >> 4;
    LAS bf16_t* Kr = (LAS bf16_t*)lds; LAS bf16_t* Vs = (LAS bf16_t*)(lds + 17408); LAS float* SEG = (LAS float*)(lds + 51200); LAS float* GLR = (LAS float*)(lds + 53248);
    const int ug = (b * NCH + n) * 4 + h;
    { const int t = tid >> 3, sg = tid & 7;
      LAS u32x4* dk = (LAS u32x4*)(Kr + t * 136 + sg * 16); dk[0] = pre.k[0]; dk[1] = pre.k[1];
      LAS u32x4* dv = (LAS u32x4*)(Vs + t * 264 + sg * 32); dv[0] = pre.v[0]; dv[1] = pre.v[1]; dv[2] = pre.v[2]; dv[3] = pre.v[3];
      if (tid < 128) { const int t2 = tid >> 1, half = tid & 1; const u32x4 w = pre.g; LAS float* gd = GLR + t2 * 16 + half * 8;
          gd[0] = bflo(w.x); gd[1] = bfhi(w.x); gd[2] = bflo(w.y); gd[3] = bfhi(w.y); gd[4] = bflo(w.z); gd[5] = bfhi(w.z); gd[6] = bflo(w.w); gd[7] = bfhi(w.w); } }
    if (has_next) gla_u_load(p, pre, b2, n2, h2, tid);
    const float gb = C.gb;
    __syncthreads();
    { const int d = tid & 127, q = tid >> 7;
      float lc[16]; float cs = 0.f;
#pragma unroll
      for (int i = 0; i < 16; ++i) { const int t = q * 16 + i; float pa = gb;
#pragma unroll
          for (int r = 0; r < 16; ++r) pa += GLR[t * 16 + r] * C.gu[r];
          cs += logsigmoid_f(pa) * 0.0625f; lc[i] = cs; }
      SEG[q * 128 + d] = cs;
      __syncthreads();
      float pref = 0.f, blast = 0.f;
#pragma unroll
      for (int q2 = 0; q2 < 4; ++q2) { const float s = SEG[q2 * 128 + d]; if (q2 < q) pref += s; blast += s; }
      float* bcg = GP(float, WS_BC) + (size_t)ug * 8192;
#pragma unroll
      for (int i = 0; i < 16; ++i) { const int t = q * 16 + i; const float bc = pref + lc[i]; const float kv = bf2f(Kr[t * 136 + d]); Kr[t * 136 + d] = f2bf(kv * __expf(blast - bc)); bcg[t * 128 + d] = bc; }
      if (q == 0) GP(float, WS_DEC)[(size_t)ug * 128 + d] = __expf(blast); }
    __syncthreads();
    { bf16x8 a[2];
#pragma unroll
      for (int ks = 0; ks < 2; ++ks) a[ks] = tr_frag(Kr, 136, 32 * ks + 8 * g4, 32 * ks + 8 * g4 + 4, 16 * wave, lane);
      u32x2* ug_ = (u32x2*)GP(bf16_t, WS_UG) + (size_t)ug * 8192 + (size_t)(wave * 16) * 64 + lane;
#pragma unroll 4
      for (int jt = 0; jt < 16; ++jt) { const bf16x8 b0 = tr_frag(Vs, 264, 8 * g4, 8 * g4 + 4, 16 * jt, lane), b1 = tr_frag(Vs, 264, 32 + 8 * g4, 36 + 8 * g4, 16 * jt, lane);
          f32x4 acc = MFMA16(a[0], b0, F4ZERO); acc = MFMA16(a[1], b1, acc); u32x2 w; w.x = pk2(acc[0], acc[1]); w.y = pk2(acc[2], acc[3]); ug_[jt * 64] = w; } }
    __syncthreads();
}

__device__ __forceinline__ void ph_gla_state(const KP& p) {
    const int tid = otid(); const int G = gridDim.x;
    const u32x2* UG = (const u32x2*)GP(const bf16_t, WS_UG); const float* DEC = GP(const float, WS_DEC); u32x2* SS = (u32x2*)GP(bf16_t, WS_SS);
    for (int gi = obid() * NTHREADS + tid; gi < BATCH * 4 * 8192; gi += G * NTHREADS) {
        const int bh = gi >> 13, e = gi & 8191, b = bh >> 2, h = bh & 3, d0 = 16 * (e >> 10) + 4 * ((e & 63) >> 4);
        const size_t ug0 = (size_t)(b * NCH * 4 + h);
        f32x4 S = F4ZERO;
        for (int n0 = 0; n0 < NCH; n0 += 8) {
            u32x2 U[8]; f32x4 dv[8];
#pragma unroll
            for (int k = 0; k < 8; ++k) { const size_t ug = ug0 + (size_t)(n0 + k) * 4; U[k] = __builtin_nontemporal_load(UG + ug * 8192 + e); dv[k] = *(const f32x4*)(DEC + ug * 128 + d0); }
#pragma unroll
            for (int k = 0; k < 8; ++k) { const size_t ug = ug0 + (size_t)(n0 + k) * 4; u32x2 w; w.x = pk2(S[0], S[1]); w.y = pk2(S[2], S[3]); __builtin_nontemporal_store(w, SS + ug * 8192 + e); S = S * dv[k] + (f32x4){bflo(U[k].x), bfhi(U[k].x), bflo(U[k].y), bfhi(U[k].y)}; }
        }
    }
}

struct TilesGLA { u32x4 q[2], k[2], v[4]; f32x4 c[4]; };
__device__ __forceinline__ void gla_out_load(const KP& p, TilesGLA& T, int b, int n, int h, int tid) {
    const int t_ = tid >> 3, sg = tid & 7, row0 = b * SEQ + n * 64, ug = (b * NCH + n) * 4 + h; const bf16_t* zr = GP(const bf16_t, WS_HB) + (size_t)(row0 + t_) * EV_NP;
    const u32x4* sq = (const u32x4*)(zr + 2048 + h * 128 + sg * 16); const u32x4* sk = (const u32x4*)(zr + 2560 + h * 128 + sg * 16); const u32x4* sv = (const u32x4*)(zr + 3072 + h * 256 + sg * 32);
    const f32x4* sb = (const f32x4*)(GP(const float, WS_BC) + (size_t)ug * 8192 + t_ * 128 + sg * 16);
    T.q[0] = sq[0]; T.q[1] = sq[1]; T.k[0] = sk[0]; T.k[1] = sk[1];
#pragma unroll
    for (int c = 0; c < 4; ++c) { T.v[c] = sv[c]; T.c[c] = sb[c]; }
}
__device__ __forceinline__ void gla_out_unit(const KP& p, int j, int b, int n, int h, LAS unsigned char* lds, TilesGLA& pre, bool has_next, int b2, int n2, int h2) {
    const int tid = otid(), lane = tid & 63, wave = __builtin_amdgcn_readfirstlane(tid >> 6), g4 = lane >> 4;
    LAS bf16_t* Qd = (LAS bf16_t*)lds; LAS bf16_t* Ki = (LAS bf16_t*)(lds + 17408); LAS bf16_t* Vs = (LAS bf16_t*)(lds + 34816); LAS bf16_t* Ps = (LAS bf16_t*)(lds + 68608); LAS float* RSs = (LAS float*)(lds + 77824); LAS float* OST = (LAS float*)lds;
    const bf16_t* Z = GP(const bf16_t, WS_HB);
    const int row0 = b * SEQ + n * 64, ug = (b * NCH + n) * 4 + h;
    const int t_ = tid >> 3, sg = tid & 7; const bf16_t* zr = Z + (size_t)(row0 + t_) * EV_NP;
    u32x4 rr[4]; u32x2 sf[2][8];
    { const u32x4 q0 = pre.q[0], q1 = pre.q[1], k0 = pre.k[0], k1 = pre.k[1], v0 = pre.v[0], v1 = pre.v[1], v2 = pre.v[2], v3 = pre.v[3]; const f32x4 c0 = pre.c[0], c1 = pre.c[1], c2 = pre.c[2], c3 = pre.c[3];
      { const u32x2* SS = (const u32x2*)GP(const bf16_t, WS_SS) + (size_t)ug * 8192 + lane;
#pragma unroll
        for (int j2 = 0; j2 < 2; ++j2)
#pragma unroll
            for (int dt = 0; dt < 8; ++dt) sf[j2][dt] = SS[(dt * 16 + 2 * wave + j2) * 64]; }
      { const u32x4* sr = (const u32x4*)(zr + 4096 + h * 256 + sg * 32); rr[0] = sr[0]; rr[1] = sr[1]; rr[2] = sr[2]; rr[3] = sr[3]; }
      LAS u32x4* dv = (LAS u32x4*)(Vs + t_ * 264 + sg * 32); dv[0] = v0; dv[1] = v1; dv[2] = v2; dv[3] = v3;
      const unsigned qw[8] = {q0.x, q0.y, q0.z, q0.w, q1.x, q1.y, q1.z, q1.w}, kw[8] = {k0.x, k0.y, k0.z, k0.w, k1.x, k1.y, k1.z, k1.w};
      const float bc[16] = {c0[0], c0[1], c0[2], c0[3], c1[0], c1[1], c1[2], c1[3], c2[0], c2[1], c2[2], c2[3], c3[0], c3[1], c3[2], c3[3]};
      unsigned qo[8], ko[8];
#pragma unroll
      for (int e = 0; e < 8; ++e) { const float e0 = __expf(bc[2 * e]), e1 = __expf(bc[2 * e + 1]);
          qo[e] = pk2(bflo(qw[e]) * 0.08838834764831845f * e0, bfhi(qw[e]) * 0.08838834764831845f * e1); ko[e] = pk2(bflo(kw[e]) * __builtin_amdgcn_rcpf(e0), bfhi(kw[e]) * __builtin_amdgcn_rcpf(e1)); }
      LAS u32x4* dq = (LAS u32x4*)(Qd + t_ * 136 + sg * 16); dq[0] = (u32x4){qo[0], qo[1], qo[2], qo[3]}; dq[1] = (u32x4){qo[4], qo[5], qo[6], qo[7]};
      LAS u32x4* dk = (LAS u32x4*)(Ki + t_ * 136 + sg * 16); dk[0] = (u32x4){ko[0], ko[1], ko[2], ko[3]}; dk[1] = (u32x4){ko[4], ko[5], ko[6], ko[7]}; }
    if (has_next) gla_out_load(p, pre, b2, n2, h2, tid);
    __syncthreads();
    { const int tt = wave >> 1, stb = (wave & 1) * 2; f32x4 acc[2] = {F4ZERO, F4ZERO};
      if (stb <= tt) {
#pragma unroll
          for (int ks = 0; ks < 4; ++ks) { const bf16x8 a = lds_frag(Qd, 136, tt * 16, ks * 32, lane);
#pragma unroll
              for (int s2 = 0; s2 < 2; ++s2) acc[s2] = MFMA16(a, lds_frag(Ki, 136, (stb + s2) * 16, ks * 32, lane), acc[s2]); } }
#pragma unroll
      for (int s2 = 0; s2 < 2; ++s2)
#pragma unroll
          for (int i = 0; i < 4; ++i) { const int t = tt * 16 + g4 * 4 + i, s = (stb + s2) * 16 + (lane & 15); Ps[t * 72 + s] = (s <= t) ? f2bf(acc[s2][i]) : (bf16_t)0; } }
    __syncthreads();
    f32x4 o[2][4];
#pragma unroll
    for (int j2 = 0; j2 < 2; ++j2)
#pragma unroll
        for (int tt = 0; tt < 4; ++tt) o[j2][tt] = F4ZERO;
#pragma unroll
    for (int k2 = 0; k2 < 2; ++k2) { bf16x8 bfr[4];
#pragma unroll
        for (int tt = 0; tt < 4; ++tt) bfr[tt] = lds_frag(Ps, 72, 16 * tt, 32 * k2, lane);
#pragma unroll
        for (int j2 = 0; j2 < 2; ++j2) { const bf16x8 a = tr_frag(Vs, 264, 32 * k2 + 8 * g4, 32 * k2 + 8 * g4 + 4, 16 * (2 * wave + j2), lane);
#pragma unroll
            for (int tt = 0; tt < 4; ++tt) o[j2][tt] = MFMA16(a, bfr[tt], o[j2][tt]); } }
#pragma unroll
    for (int ks = 0; ks < 4; ++ks) { bf16x8 bfr[4];
#pragma unroll
        for (int tt = 0; tt < 4; ++tt) bfr[tt] = lds_frag_perm(Qd, 136, 16 * tt, 32 * ks, lane);
#pragma unroll
        for (int j2 = 0; j2 < 2; ++j2) { const u32x4 w = {sf[j2][2 * ks].x, sf[j2][2 * ks].y, sf[j2][2 * ks + 1].x, sf[j2][2 * ks + 1].y}; const bf16x8 a = __builtin_bit_cast(bf16x8, w);
#pragma unroll
            for (int tt = 0; tt < 4; ++tt) o[j2][tt] = MFMA16(a, bfr[tt], o[j2][tt]); } }
#pragma unroll
    for (int tt = 0; tt < 4; ++tt) { float ss = 0.f;
#pragma unroll
        for (int j2 = 0; j2 < 2; ++j2) ss += (o[j2][tt][0] * o[j2][tt][0] + o[j2][tt][1] * o[j2][tt][1]) + (o[j2][tt][2] * o[j2][tt][2] + o[j2][tt][3] * o[j2][tt][3]);
        ss += __shfl_xor(ss, 16); ss += __shfl_xor(ss, 32);
        if (lane < 16) RSs[wave * 64 + 16 * tt + lane] = ss; }
    __syncthreads();
#pragma unroll
    for (int tt = 0; tt < 4; ++tt) { const int t = 16 * tt + (lane & 15); float tot = 0.f;
#pragma unroll
        for (int w2 = 0; w2 < 8; ++w2) tot += RSs[w2 * 64 + t];
        const float rs = rsqrtf(tot * (1.0f / 256.0f) + EPS);
#pragma unroll
        for (int j2 = 0; j2 < 2; ++j2) *(LAS f32x4*)(OST + t * 260 + 16 * (2 * wave + j2) + 4 * g4) = o[j2][tt] * rs; }
    __syncthreads();
    { const f32x4* gn = (const f32x4*)(p.in[I_GNORM] + j * 1024 + h * 256 + sg * 32);
      u32x4* dst = (u32x4*)(GP(bf16_t, WS_U) + mix_off(row0 + t_, 1024 + h * 256 + sg * 32));
#pragma unroll
      for (int c = 0; c < 4; ++c) { const u32x4 rw = rr[c]; const f32x4 oa = *(const LAS f32x4*)(OST + t_ * 260 + sg * 32 + 8 * c), ob = *(const LAS f32x4*)(OST + t_ * 260 + sg * 32 + 8 * c + 4), ga = gn[2 * c], gb = gn[2 * c + 1];
          u32x4 w; w.x = pk2(oa[0] * ga[0] * pg8::silu_f(bflo(rw.x)), oa[1] * ga[1] * pg8::silu_f(bfhi(rw.x))); w.y = pk2(oa[2] * ga[2] * pg8::silu_f(bflo(rw.y)), oa[3] * ga[3] * pg8::silu_f(bfhi(rw.y)));
          w.z = pk2(ob[0] * gb[0] * pg8::silu_f(bflo(rw.z)), ob[1] * gb[1] * pg8::silu_f(bfhi(rw.z))); w.w = pk2(ob[2] * gb[2] * pg8::silu_f(bflo(rw.w)), ob[3] * gb[3] * pg8::silu_f(bfhi(rw.w)));
          dst[c] = w; } }
    __syncthreads();
}

__device__ __forceinline__ void lru_fix_unit(const KP& p, int b, int np, LAS unsigned char* lds) {
    const int tid = otid(); const int c8 = tid & 127, c = 8 * c8, rq = tid >> 7;
    LAS float* CQ = (LAS float*)lds;
    const float* CA = GP(const float, WS_CARA) + (size_t)b * NCH * 1024 + c; const float* CH = GP(const float, WS_CARH) + (size_t)b * NCH * 1024 + c;
    float H[8];
    { const int nprev = 2 * np, per = (nprev + 3) >> 2, lo = rq * per, hi = (lo + per < nprev) ? lo + per : nprev;
      float Aq[8], Hq[8];
#pragma unroll
      for (int e = 0; e < 8; ++e) { Aq[e] = 1.f; Hq[e] = 0.f; }
      for (int n0 = lo; n0 < hi; n0 += 8) {
          f32x4 a[8][2], hh[8][2];
#pragma unroll
          for (int k = 0; k < 8; ++k) { const bool ok = n0 + k < hi; const size_t o = (size_t)(ok ? n0 + k : 0) * 1024;
              a[k][0] = *(const f32x4*)(CA + o); a[k][1] = *(const f32x4*)(CA + o + 4); hh[k][0] = *(const f32x4*)(CH + o); hh[k][1] = *(const f32x4*)(CH + o + 4);
              if (!ok) { a[k][0] = (f32x4){1.f, 1.f, 1.f, 1.f}; a[k][1] = a[k][0]; hh[k][0] = F4ZERO; hh[k][1] = F4ZERO; } }
#pragma unroll
          for (int k = 0; k < 8; ++k)
#pragma unroll
              for (int e = 0; e < 8; ++e) { Hq[e] = a[k][e >> 2][e & 3] * Hq[e] + hh[k][e >> 2][e & 3]; Aq[e] *= a[k][e >> 2][e & 3]; }
      }
      LAS f32x4* dq = (LAS f32x4*)(CQ + (rq * 128 + c8) * 16);
      dq[0] = (f32x4){Aq[0], Aq[1], Aq[2], Aq[3]}; dq[1] = (f32x4){Aq[4], Aq[5], Aq[6], Aq[7]}; dq[2] = (f32x4){Hq[0], Hq[1], Hq[2], Hq[3]}; dq[3] = (f32x4){Hq[4], Hq[5], Hq[6], Hq[7]};
      __syncthreads();
#pragma unroll
      for (int e = 0; e < 8; ++e) H[e] = 0.f;
#pragma unroll
      for (int q2 = 0; q2 < 4; ++q2) { const LAS f32x4* sq = (const LAS f32x4*)(CQ + (q2 * 128 + c8) * 16); const f32x4 a0 = sq[0], a1 = sq[1], h0 = sq[2], h1 = sq[3];
#pragma unroll
          for (int e = 0; e < 4; ++e) { H[e] = a0[e] * H[e] + h0[e]; H[4 + e] = a1[e] * H[4 + e] + h1[e]; } }
      __syncthreads(); }
    for (int half = 0; half < 2; ++half) { const int n = 2 * np + half, row0 = b * SEQ + n * 64 + rq * 16;
        const bf16_t* hl = GP(const bf16_t, WS_HLOC) + (size_t)row0 * 1024 + c; const bf16_t* ap = GP(const bf16_t, WS_APROD) + (size_t)row0 * 1024 + c;
        const bf16_t* yb = GP(const bf16_t, WS_HB) + (size_t)row0 * EV_NP + 1024 + c; bf16_t* mix = GP(bf16_t, WS_U);
        const f32x4 an0 = *(const f32x4*)(CA + (size_t)n * 1024), an1 = *(const f32x4*)(CA + (size_t)n * 1024 + 4), hn0 = *(const f32x4*)(CH + (size_t)n * 1024), hn1 = *(const f32x4*)(CH + (size_t)n * 1024 + 4);
        for (int t0 = 0; t0 < 16; t0 += 8) {
            u32x4 wh[8], wa[8], wy[8];
#pragma unroll
            for (int k = 0; k < 8; ++k) { wh[k] = *(const u32x4*)(hl + (size_t)(t0 + k) * 1024); wa[k] = *(const u32x4*)(ap + (size_t)(t0 + k) * 1024); wy[k] = *(const u32x4*)(yb + (size_t)(t0 + k) * EV_NP); }
#pragma unroll
            for (int k = 0; k < 8; ++k) { const unsigned h4[4] = {wh[k].x, wh[k].y, wh[k].z, wh[k].w}, a4[4] = {wa[k].x, wa[k].y, wa[k].z, wa[k].w}, y4[4] = {wy[k].x, wy[k].y, wy[k].z, wy[k].w}; unsigned o4[4];
#pragma unroll
                for (int e = 0; e < 4; ++e) { const float h0 = bflo(h4[e]) + bflo(a4[e]) * H[2 * e], h1 = bfhi(h4[e]) + bfhi(a4[e]) * H[2 * e + 1]; o4[e] = pk2(h0 * gelu_tanh_f(bflo(y4[e])), h1 * gelu_tanh_f(bfhi(y4[e]))); }
                *(u32x4*)(mix + mix_off(row0 + t0 + k, c)) = (u32x4){o4[0], o4[1], o4[2], o4[3]}; }
        }
#pragma unroll
        for (int e = 0; e < 4; ++e) { H[e] = an0[e] * H[e] + hn0[e]; H[4 + e] = an1[e] * H[4 + e] + hn1[e]; }
    }
}

__device__ __forceinline__ void mlstm_tok_unit(const KP& p, int j, int b, int n, LAS unsigned char* lds) {
    const int tid = otid(), lane = tid & 63, wave = tid >> 6;
    LAS float* RED = (LAS float*)lds;
    const bf16_t* Z = GP(const bf16_t, WS_HB);
    const int g = tid & 255, th = tid >> 8, c = 4 * g, row0 = b * SEQ + n * 64, t0 = th * 32, pos0 = n * 64 + t0;
    LAS float* EQ = (LAS float*)(lds + 8192); LAS float* EV = (LAS float*)(lds + 8192 + 32768);
    float cw[4][4], cb[4], wq[4][4], wk[4][4], wv[4][4];
#pragma unroll
    for (int k = 0; k < 4; ++k)
#pragma unroll
        for (int i = 0; i < 4; ++i) cw[k][i] = p.in[I_MCW][(size_t)(j * 4 + k) * 1024 + c + i];
#pragma unroll
    for (int i = 0; i < 4; ++i) cb[i] = p.in[I_MCB][j * 1024 + c + i];
#pragma unroll
    for (int i = 0; i < 4; ++i)
#pragma unroll
        for (int jj = 0; jj < 4; ++jj) { const size_t wi = ((size_t)(j * 256 + g) * 4 + i) * 4 + jj; wq[i][jj] = p.in[I_MWQ][wi]; wk[i][jj] = p.in[I_MWK][wi]; wv[i][jj] = p.in[I_MWV][wi]; }
    { const float* wif = p.in[I_MWIF] + (size_t)j * 3072 * 8;
#pragma unroll
      for (int i = 0; i < 4; ++i)
#pragma unroll
          for (int G = 0; G < 8; ++G) { float a = 0.f, v = 0.f;
#pragma unroll
              for (int jj = 0; jj < 4; ++jj) { a += wq[i][jj] * wif[(size_t)(c + jj) * 8 + G] + wk[i][jj] * wif[(size_t)(1024 + c + jj) * 8 + G]; v += wv[i][jj] * wif[(size_t)(2048 + c + jj) * 8 + G]; }
              EQ[(i * 8 + G) * 256 + g] = a; EV[(i * 8 + G) * 256 + g] = v; } }
    const bf16_t* zp = Z + (size_t)row0 * OD_N + c;
    float x3[4] = {0.f, 0.f, 0.f, 0.f}, x2[4] = {0.f, 0.f, 0.f, 0.f}, x1[4] = {0.f, 0.f, 0.f, 0.f};
    if (pos0 >= 3) { const u32x2 w = *(const u32x2*)(zp + (ptrdiff_t)(t0 - 3) * OD_N); x3[0] = bflo(w.x); x3[1] = bfhi(w.x); x3[2] = bflo(w.y); x3[3] = bfhi(w.y); }
    if (pos0 >= 2) { const u32x2 w = *(const u32x2*)(zp + (ptrdiff_t)(t0 - 2) * OD_N); x2[0] = bflo(w.x); x2[1] = bfhi(w.x); x2[2] = bflo(w.y); x2[3] = bfhi(w.y); }
    if (pos0 >= 1) { const u32x2 w = *(const u32x2*)(zp + (ptrdiff_t)(t0 - 1) * OD_N); x1[0] = bflo(w.x); x1[1] = bfhi(w.x); x1[2] = bflo(w.y); x1[3] = bfhi(w.y); }
    bf16_t* XC = GP(bf16_t, WS_XC) + (size_t)row0 * 1024 + c; bf16_t* Qb = GP(bf16_t, WS_Q) + (size_t)row0 * 1024 + c; bf16_t* Kb = GP(bf16_t, WS_KB) + (size_t)row0 * 1024 + c; bf16_t* Vb = GP(bf16_t, WS_V) + (size_t)row0 * 1024 + c;
    for (int i0 = 0; i0 < 32; i0 += 8) {
        u32x2 xw[8];
#pragma unroll
        for (int k8 = 0; k8 < 8; ++k8) xw[k8] = *(const u32x2*)(zp + (size_t)(t0 + i0 + k8) * OD_N);
#pragma unroll
        for (int k8 = 0; k8 < 8; ++k8) { const int t = t0 + i0 + k8; const u32x2 w = xw[k8];
        float xm[4] = {bflo(w.x), bfhi(w.x), bflo(w.y), bfhi(w.y)}; float xc[4], q[4], k[4], v[4];
#pragma unroll
        for (int ch = 0; ch < 4; ++ch) { const float a = cw[0][ch] * x3[ch] + cw[1][ch] * x2[ch] + cw[2][ch] * x1[ch] + cw[3][ch] * xm[ch] + cb[ch]; xc[ch] = pg8::silu_f(a); x3[ch] = x2[ch]; x2[ch] = x1[ch]; x1[ch] = xm[ch]; }
#pragma unroll
        for (int jj = 0; jj < 4; ++jj) { q[jj] = xc[0] * wq[0][jj] + xc[1] * wq[1][jj] + xc[2] * wq[2][jj] + xc[3] * wq[3][jj]; k[jj] = xc[0] * wk[0][jj] + xc[1] * wk[1][jj] + xc[2] * wk[2][jj] + xc[3] * wk[3][jj];
            v[jj] = xm[0] * wv[0][jj] + xm[1] * wv[1][jj] + xm[2] * wv[2][jj] + xm[3] * wv[3][jj]; }
        { u32x2 o; o.x = pk2(xc[0], xc[1]); o.y = pk2(xc[2], xc[3]); *(u32x2*)(XC + (size_t)t * 1024) = o; }
        { u32x2 o; o.x = pk2(q[0], q[1]); o.y = pk2(q[2], q[3]); *(u32x2*)(Qb + (size_t)t * 1024) = o; }
        { u32x2 o; o.x = pk2(k[0] * 0.0625f, k[1] * 0.0625f); o.y = pk2(k[2] * 0.0625f, k[3] * 0.0625f); *(u32x2*)(Kb + (size_t)t * 1024) = o; }
        { u32x2 o; o.x = pk2(v[0], v[1]); o.y = pk2(v[2], v[3]); *(u32x2*)(Vb + (size_t)t * 1024) = o; }
        float gp[8];
#pragma unroll
        for (int G = 0; G < 8; ++G) gp[G] = (xc[0] * EQ[(0 * 8 + G) * 256 + g] + xc[1] * EQ[(1 * 8 + G) * 256 + g]) + (xc[2] * EQ[(2 * 8 + G) * 256 + g] + xc[3] * EQ[(3 * 8 + G) * 256 + g]) + (xm[0] * EV[(0 * 8 + G) * 256 + g] + xm[1] * EV[(1 * 8 + G) * 256 + g]) + (xm[2] * EV[(2 * 8 + G) * 256 + g] + xm[3] * EV[(3 * 8 + G) * 256 + g]);
        float r4[4], r2[2], r1;
        { const bool hi = (lane & 32) != 0;
#pragma unroll
          for (int q4 = 0; q4 < 4; ++q4) { const float keep = hi ? gp[4 + q4] : gp[q4], send = hi ? gp[q4] : gp[4 + q4]; r4[q4] = keep + __shfl_xor(send, 32); } }
        { const bool hi = (lane & 16) != 0;
#pragma unroll
          for (int q2 = 0; q2 < 2; ++q2) { const float keep = hi ? r4[2 + q2] : r4[q2], send = hi ? r4[q2] : r4[2 + q2]; r2[q2] = keep + __shfl_xor(send, 16); } }
        { const bool hi = (lane & 8) != 0; const float keep = hi ? r2[1] : r2[0], send = hi ? r2[0] : r2[1]; r1 = keep + __shfl_xor(send, 8); }
        r1 += __shfl_xor(r1, 4); r1 += __shfl_xor(r1, 2); r1 += __shfl_xor(r1, 1);
        if ((lane & 7) == 0) RED[(t * 4 + (wave & 3)) * 8 + ((lane >> 3) & 7)] = r1;
        }
    }
    __syncthreads();
    { const int t = tid >> 3, G = tid & 7; const float s = p.in[I_MBIF][j * 8 + G] + (RED[(t * 4 + 0) * 8 + G] + RED[(t * 4 + 1) * 8 + G]) + (RED[(t * 4 + 2) * 8 + G] + RED[(t * 4 + 3) * 8 + G]);
      GP(float, WS_GATES)[(size_t)(row0 + t) * 8 + G] = s; }
    __syncthreads();
}

struct PoolPre { u32x4 rv[5]; };
__device__ __forceinline__ void pool_load(const KP& p, PoolPre& P, int b, int n, int g, int tid) {
    const bf16_t* Z = GP(const bf16_t, WS_HB); const int row0 = b * SEQ + n * 64;
#pragma unroll
    for (int k = 0; k < 5; ++k) { const int idx = tid + NTHREADS * k, rr = idx >> 5, sg = idx & 31; P.rv[k] = (u32x4){0u, 0u, 0u, 0u};
        if (idx < 79 * 32 && n * 64 + rr - 15 >= 0) P.rv[k] = *(const u32x4*)(Z + (size_t)(row0 + rr - 15) * OD_N + 2048 + g * 256 + sg * 8); }
}
__device__ __forceinline__ void pool_unit(const KP& p, int j, int b, int n, int g, LAS unsigned char* lds, PoolPre& pre) {
    const int tid = otid(), lane = tid & 63, wave = __builtin_amdgcn_readfirstlane(tid >> 6);
    LAS bf16_t* R = (LAS bf16_t*)lds;
    LAS bf16_t* A = (LAS bf16_t*)(lds + 41728);
    const int row0 = b * SEQ + n * 64;
    bf16x8 pf[2][8];
    { const bf16_t* PT = GP(const bf16_t, WS_POOLT) + (size_t)g * 65536;
#pragma unroll
      for (int jt = 0; jt < 2; ++jt)
#pragma unroll
          for (int ks = 0; ks < 8; ++ks) pf[jt][ks] = glb_frag(PT, 256, (2 * wave + jt) * 16, ks * 32, lane); }
#pragma unroll
    for (int k = 0; k < 5; ++k) { const int idx = tid + NTHREADS * k, rr = idx >> 5, sg = idx & 31; if (idx < 79 * 32) *(LAS u32x4*)(R + rr * 264 + sg * 8) = pre.rv[k]; }
    if (g < 3) pool_load(p, pre, b, n, g + 1, tid);
    __syncthreads();
    { const int c = tid & 255, th = tid >> 8, win = 2 << g, t0 = th * 32, pos0 = n * 64 + t0;
      float S = 0.f;
      for (int k = 1; k < win; ++k) S += bf2f(R[(15 + t0 - k) * 264 + c]);
#pragma unroll 8
      for (int i = 0; i < 32; ++i) { const int t = t0 + i, pos = pos0 + i; const float xv = bf2f(R[(15 + t) * 264 + c]); S += xv;
          const float cnt = (float)((pos + 1 < win) ? pos + 1 : win); A[t * 264 + c] = f2bf(S / cnt - xv);
          S -= bf2f(R[(15 + t - win + 1) * 264 + c]); } }
    __syncthreads();
    { f32x4 acc[2][4];
#pragma unroll
      for (int jt = 0; jt < 2; ++jt)
#pragma unroll
          for (int tt = 0; tt < 4; ++tt) acc[jt][tt] = F4ZERO;
#pragma unroll
      for (int ks = 0; ks < 8; ++ks) {
          bf16x8 bfr[4];
#pragma unroll
          for (int tt = 0; tt < 4; ++tt) bfr[tt] = lds_frag(A, 264, tt * 16, ks * 32, lane);
#pragma unroll
          for (int jt = 0; jt < 2; ++jt)
#pragma unroll
              for (int tt = 0; tt < 4; ++tt) acc[jt][tt] = MFMA16(pf[jt][ks], bfr[tt], acc[jt][tt]); }
      bf16_t* MIX = GP(bf16_t, WS_U);
#pragma unroll
      for (int jt = 0; jt < 2; ++jt) { const int jj = (2 * wave + jt) * 16 + (lane >> 4) * 4; const f32x4 sc = *(const f32x4*)(p.in[I_POOLS] + j * 1024 + g * 256 + jj);
#pragma unroll
          for (int tt = 0; tt < 4; ++tt) { const int t = tt * 16 + (lane & 15); const f32x4 o = acc[jt][tt] * sc; u32x2 w; w.x = pk2(o[0], o[1]); w.y = pk2(o[2], o[3]);
              *(u32x2*)(MIX + mix_off(row0 + t, 1024 + g * 256 + jj)) = w; } } }
    __syncthreads();
}

struct MuPre { u32x4 k[4], v[4]; float iv, gf; };
__device__ __forceinline__ void mlstm_u_load(const KP& p, MuPre& P, int b, int n, int h, int tid) {
    const int row0 = b * SEQ + n * 64, t = tid >> 3, sg = tid & 7;
    const u32x4* sk = (const u32x4*)(GP(const bf16_t, WS_KB) + (size_t)(row0 + t) * 1024 + h * 256 + sg * 32); const u32x4* sv = (const u32x4*)(GP(const bf16_t, WS_V) + (size_t)(row0 + t) * 1024 + h * 256 + sg * 32);
#pragma unroll
    for (int c = 0; c < 4; ++c) { P.k[c] = sk[c]; P.v[c] = sv[c]; }
    if (tid < 64) { const float* gt = GP(const float, WS_GATES) + (size_t)(row0 + tid) * 8; P.iv = gt[h]; P.gf = gt[4 + h]; }
}
__device__ __forceinline__ void mlstm_u_unit(const KP& p, int b, int n, int h, LAS unsigned char* lds, MuPre& pre, PoolPre& ppre) {
    const int tid = otid(), lane = tid & 63, wave = __builtin_amdgcn_readfirstlane(tid >> 6), g4 = lane >> 4;
    LAS bf16_t* Ks = (LAS bf16_t*)lds; LAS bf16_t* Vw = (LAS bf16_t*)(lds + 33792); LAS float* wl = (LAS float*)(lds + 67584);
    const int row0 = b * SEQ + n * 64, ug = (b * NCH + n) * 4 + h; (void)row0;
    if (wave == 0) { const int t = lane; const float iv = pre.iv, lf = logsigmoid_f(pre.gf);
        float bcum = lf;
#pragma unroll
        for (int o = 1; o < 64; o <<= 1) { const float v = __shfl_up(bcum, o); if (lane >= o) bcum += v; }
        const float bL = __shfl(bcum, 63), gg = bL - bcum + iv, mg = wave_max(gg);
        wl[t] = __expf(gg - mg);
        if (lane == 0) { GP(float, WS_SC)[ug * 2] = bL; GP(float, WS_SC)[ug * 2 + 1] = mg; } }
    const int t = tid >> 3, sg = tid & 7;
    u32x4 vv[4];
    { LAS u32x4* dk = (LAS u32x4*)(Ks + t * 264 + sg * 32); dk[0] = pre.k[0]; dk[1] = pre.k[1]; dk[2] = pre.k[2]; dk[3] = pre.k[3]; vv[0] = pre.v[0]; vv[1] = pre.v[1]; vv[2] = pre.v[2]; vv[3] = pre.v[3]; }
    if (h < 3) mlstm_u_load(p, pre, b, n, h + 1, tid); else pool_load(p, ppre, b, n, 0, tid);
    __syncthreads();
    { const float w = wl[t]; LAS u32x4* dv = (LAS u32x4*)(Vw + t * 264 + sg * 32);
#pragma unroll
      for (int c = 0; c < 4; ++c) { u32x4 o; o.x = pk2(bflo(vv[c].x) * w, bfhi(vv[c].x) * w); o.y = pk2(bflo(vv[c].y) * w, bfhi(vv[c].y) * w); o.z = pk2(bflo(vv[c].z) * w, bfhi(vv[c].z) * w); o.w = pk2(bflo(vv[c].w) * w, bfhi(vv[c].w) * w); dv[c] = o; } }
    __syncthreads();
    { bf16x8 a[2][2];
#pragma unroll
      for (int d2 = 0; d2 < 2; ++d2)
#pragma unroll
          for (int ks = 0; ks < 2; ++ks) a[d2][ks] = tr_frag(Ks, 264, 32 * ks + 8 * g4, 32 * ks + 8 * g4 + 4, 16 * (2 * wave + d2), lane);
      u32x2* um = (u32x2*)GP(bf16_t, WS_UM) + (size_t)ug * 16384 + lane;
#pragma unroll 4
      for (int jt = 0; jt < 16; ++jt) { const bf16x8 b0 = tr_frag(Vw, 264, 8 * g4, 8 * g4 + 4, 16 * jt, lane), b1 = tr_frag(Vw, 264, 32 + 8 * g4, 36 + 8 * g4, 16 * jt, lane);
#pragma unroll
          for (int d2 = 0; d2 < 2; ++d2) { f32x4 acc = MFMA16(a[d2][0], b0, F4ZERO); acc = MFMA16(a[d2][1], b1, acc); u32x2 w; w.x = pk2(acc[0], acc[1]); w.y = pk2(acc[2], acc[3]); um[((2 * wave + d2) * 16 + jt) * 64] = w; } } }
    if (tid < 256) { float s = 0.f;
#pragma unroll 8
        for (int s2 = 0; s2 < 64; ++s2) s += wl[s2] * bf2f(Ks[s2 * 264 + tid]);
        GP(float, WS_NU)[(size_t)ug * 256 + tid] = s; }
    __syncthreads();
}

__device__ __forceinline__ void ph_mlstm_state(const KP& p) {
    const int tid = otid(); const int G = gridDim.x, blk = obid();
    const u32x2* UM = (const u32x2*)GP(const bf16_t, WS_UM); u32x2* CS = (u32x2*)GP(bf16_t, WS_CS); const float* SC = GP(const float, WS_SC);
    const float* NU = GP(const float, WS_NU); float* NS = GP(float, WS_NS); float* MS = GP(float, WS_MS);
    int ci = tid < 4 ? blk * 4 + tid : (1 << 30);
    for (int gi = blk * NTHREADS + tid; gi < BATCH * 4 * 16384; gi += G * NTHREADS) {
        const int bh = gi >> 14, e = gi & 16383; const size_t ug0 = (size_t)((bh >> 2) * NCH * 4 + (bh & 3));
        const bool have = ci < BATCH * 4 * 64; const int bh2 = have ? ci >> 6 : 0, d4 = ci & 63; const size_t vg0 = (size_t)((bh2 >> 2) * NCH * 4 + (bh2 & 3));
        f32x4 C = F4ZERO, nv = F4ZERO; float m = 0.f, m2 = 0.f;
        for (int n0 = 0; n0 < NCH; n0 += 16) {
            u32x2 uw[16]; float2 sc2[16];
#pragma unroll
            for (int k = 0; k < 16; ++k) { const size_t ug = ug0 + (size_t)(n0 + k) * 4; uw[k] = __builtin_nontemporal_load(UM + ug * 16384 + e); sc2[k] = *(const float2*)(SC + ug * 2); }
            if (have) {
                f32x4 nu[16]; float2 sd2[16];
#pragma unroll
                for (int k = 0; k < 16; ++k) { const size_t vg = vg0 + (size_t)(n0 + k) * 4; nu[k] = *(const f32x4*)(NU + vg * 256 + 4 * d4); sd2[k] = *(const float2*)(SC + vg * 2); }
#pragma unroll
                for (int k = 0; k < 16; ++k) { const size_t vg = vg0 + (size_t)(n0 + k) * 4; const float bL = sd2[k].x, mg = sd2[k].y;
                    *(f32x4*)(NS + vg * 256 + 4 * d4) = nv; if (d4 == 0) MS[vg] = m2;
                    const float m_new = fmaxf(bL + m2, mg), decay = __expf(bL + m2 - m_new), sc = __expf(mg - m_new);
                    nv = nv * decay + nu[k] * sc; m2 = m_new; } }
#pragma unroll
            for (int k = 0; k < 16; ++k) { const size_t ug = ug0 + (size_t)(n0 + k) * 4; const float bL = sc2[k].x, mg = sc2[k].y;
                u32x2 w; w.x = pk2(C[0], C[1]); w.y = pk2(C[2], C[3]); __builtin_nontemporal_store(w, CS + ug * 16384 + e);
                const float m_new = fmaxf(bL + m, mg), decay = __expf(bL + m - m_new), sc = __expf(mg - m_new);
                C = C * decay + (f32x4){bflo(uw[k].x), bfhi(uw[k].x), bflo(uw[k].y), bfhi(uw[k].y)} * sc; m = m_new; }
        }
        if (have) ci += 4 * G;
    }
    for (; ci < BATCH * 4 * 64; ci += 4 * G) {
        const int bh2 = ci >> 6, d4 = ci & 63; const size_t vg0 = (size_t)((bh2 >> 2) * NCH * 4 + (bh2 & 3)); f32x4 nv = F4ZERO; float m2 = 0.f;
        for (int n = 0; n < NCH; ++n) { const size_t vg = vg0 + (size_t)n * 4; const f32x4 nu = *(const f32x4*)(NU + vg * 256 + 4 * d4); const float bL = SC[vg * 2], mg = SC[vg * 2 + 1];
            *(f32x4*)(NS + vg * 256 + 4 * d4) = nv; if (d4 == 0) MS[vg] = m2;
            const float m_new = fmaxf(bL + m2, mg), decay = __expf(bL + m2 - m_new), sc = __expf(mg - m_new); nv = nv * decay + nu * sc; m2 = m_new; }
    }
}

struct TilesML { u32x4 q[4], k[4], v[4]; };
__device__ __forceinline__ void mlstm_out_load(const KP& p, TilesML& T, int b, int n, int h, int tid) {
    const size_t ro = (size_t)(b * SEQ + n * 64 + (tid >> 3)) * 1024 + h * 256 + (tid & 7) * 32;
    const u32x4* sq = (const u32x4*)(GP(const bf16_t, WS_Q) + ro); const u32x4* sk = (const u32x4*)(GP(const bf16_t, WS_KB) + ro); const u32x4* sv = (const u32x4*)(GP(const bf16_t, WS_V) + ro);
#pragma unroll
    for (int c = 0; c < 4; ++c) { T.q[c] = sq[c]; T.k[c] = sk[c]; T.v[c] = sv[c]; }
}
__device__ __forceinline__ void mlstm_out_unit(const KP& p, int j, int b, int n, int h, LAS unsigned char* lds, TilesML& pre, bool has_next, int b2, int n2, int h2) {
    const int tid = otid(), lane = tid & 63, wave = __builtin_amdgcn_readfirstlane(tid >> 6), g4 = lane >> 4;
    LAS bf16_t* Qs = (LAS bf16_t*)lds; LAS bf16_t* Ks = (LAS bf16_t*)(lds + 33792); LAS bf16_t* Vs = (LAS bf16_t*)(lds + 67584);
    LAS float* bc = (LAS float*)(lds + 101376); LAS float* ig = bc + 64; LAS float* ml = bc + 128; LAS float* qnp = (LAS float*)(lds + 102144); LAS float* RSs = (LAS float*)(lds + 104192); LAS float* nvec = (LAS float*)(lds + 106240);
    LAS bf16_t* Ps = (LAS bf16_t*)(lds + 107264); LAS float* denp = (LAS float*)(lds + 116480); LAS float* OST = (LAS float*)lds;
    const int row0 = b * SEQ + n * 64, ug = (b * NCH + n) * 4 + h;
    const int t_ = tid >> 3, sg = tid & 7, c0 = h * 256 + sg * 32;
    u32x2 cf[2][16];
    { const u32x2* CS = (const u32x2*)GP(const bf16_t, WS_CS) + (size_t)ug * 16384 + lane;
#pragma unroll
      for (int j2 = 0; j2 < 2; ++j2)
#pragma unroll
          for (int dt = 0; dt < 16; ++dt) cf[j2][dt] = CS[(dt * 16 + 2 * wave + j2) * 64]; }
    if (wave == 0) { const int t = lane; const float* gt = GP(const float, WS_GATES) + (size_t)(row0 + t) * 8; const float iv = gt[h], lf = logsigmoid_f(gt[4 + h]);
        float bcum = lf;
#pragma unroll
        for (int o = 1; o < 64; o <<= 1) { const float v = __shfl_up(bcum, o); if (lane >= o) bcum += v; }
        float pm = iv - bcum;
#pragma unroll
        for (int o = 1; o < 64; o <<= 1) { const float v = __shfl_up(pm, o); if (lane >= o) pm = fmaxf(pm, v); }
        bc[t] = bcum; ig[t] = iv; ml[t] = bcum + pm; }
    { LAS u32x4* dq = (LAS u32x4*)(Qs + t_ * 264 + sg * 32); LAS u32x4* dk = (LAS u32x4*)(Ks + t_ * 264 + sg * 32); LAS u32x4* dv = (LAS u32x4*)(Vs + t_ * 264 + sg * 32);
#pragma unroll
      for (int c = 0; c < 4; ++c) { dq[c] = pre.q[c]; dk[c] = pre.k[c]; dv[c] = pre.v[c]; }
      if (tid < 256) nvec[tid] = GP(const float, WS_NS)[(size_t)ug * 256 + tid]; }
    const float m = GP(const float, WS_MS)[ug];
    __syncthreads();
    { const int t = tid & 63, part = tid >> 6; float s = 0.f;
#pragma unroll
      for (int dd = 0; dd < 32; dd += 2) { const unsigned w = *(const LAS unsigned*)(Qs + t * 264 + part * 32 + dd); s += bflo(w) * nvec[part * 32 + dd] + bfhi(w) * nvec[part * 32 + dd + 1]; }
      qnp[part * 64 + t] = s; }
    { const int tt = wave >> 1, stb = (wave & 1) * 2; f32x4 acc[2] = {F4ZERO, F4ZERO};
      if (stb <= tt) {
#pragma unroll
          for (int ks = 0; ks < 8; ++ks) { const bf16x8 a = lds_frag(Qs, 264, tt * 16, ks * 32, lane);
#pragma unroll
              for (int s2 = 0; s2 < 2; ++s2) acc[s2] = MFMA16(a, lds_frag(Ks, 264, (stb + s2) * 16, ks * 32, lane), acc[s2]); } }
#pragma unroll
      for (int s2 = 0; s2 < 2; ++s2) { const int s = (stb + s2) * 16 + (lane & 15); const float es = ig[s] - bc[s];
#pragma unroll
          for (int i = 0; i < 4; ++i) { const int t = tt * 16 + g4 * 4 + i; float pv = (s <= t) ? acc[s2][i] * __expf(bc[t] + es - ml[t]) : 0.f; Ps[t * 72 + s] = f2bf(pv);
              pv += __shfl_xor(pv, 1); pv += __shfl_xor(pv, 2); pv += __shfl_xor(pv, 4); pv += __shfl_xor(pv, 8);
              if ((lane & 15) == 0) denp[t * 4 + stb + s2] = pv; } } }
    u32x4 xr[4], zq[4];
    { const u32x4* sx = (const u32x4*)(GP(const bf16_t, WS_XC) + (size_t)(row0 + t_) * 1024 + c0); const u32x4* sz = (const u32x4*)(GP(const bf16_t, WS_HB) + (size_t)(row0 + t_) * OD_N + 1024 + c0);
#pragma unroll
      for (int c = 0; c < 4; ++c) { xr[c] = sx[c]; zq[c] = sz[c]; } }
    if (has_next) mlstm_out_load(p, pre, b2, n2, h2, tid);
    __syncthreads();
    f32x4 aN[2][4], aI[2][4];
#pragma unroll
    for (int j2 = 0; j2 < 2; ++j2)
#pragma unroll
        for (int tt = 0; tt < 4; ++tt) { aN[j2][tt] = F4ZERO; aI[j2][tt] = F4ZERO; }
#pragma unroll
    for (int k2 = 0; k2 < 2; ++k2) { bf16x8 bfr[4];
#pragma unroll
        for (int tt = 0; tt < 4; ++tt) bfr[tt] = lds_frag(Ps, 72, 16 * tt, 32 * k2, lane);
#pragma unroll
        for (int j2 = 0; j2 < 2; ++j2) { const bf16x8 a = tr_frag(Vs, 264, 32 * k2 + 8 * g4, 32 * k2 + 8 * g4 + 4, 16 * (2 * wave + j2), lane);
#pragma unroll
            for (int tt = 0; tt < 4; ++tt) aN[j2][tt] = MFMA16(a, bfr[tt], aN[j2][tt]); } }
#pragma unroll
    for (int ks = 0; ks < 8; ++ks) { bf16x8 bfr[4];
#pragma unroll
        for (int tt = 0; tt < 4; ++tt) bfr[tt] = lds_frag_perm(Qs, 264, 16 * tt, 32 * ks, lane);
#pragma unroll
        for (int j2 = 0; j2 < 2; ++j2) { const u32x4 w = {cf[j2][2 * ks].x, cf[j2][2 * ks].y, cf[j2][2 * ks + 1].x, cf[j2][2 * ks + 1].y}; const bf16x8 a = __builtin_bit_cast(bf16x8, w);
#pragma unroll
            for (int tt = 0; tt < 4; ++tt) aI[j2][tt] = MFMA16(a, bfr[tt], aI[j2][tt]); } }
#pragma unroll
    for (int tt = 0; tt < 4; ++tt) { const int t = 16 * tt + (lane & 15); float qn = 0.f;
#pragma unroll
        for (int pp = 0; pp < 8; ++pp) qn += qnp[pp * 64 + t];
        const float denl = (denp[t * 4] + denp[t * 4 + 1]) + (denp[t * 4 + 2] + denp[t * 4 + 3]);
        const float mt = fmaxf(bc[t] + m, ml[t]), el = __expf(ml[t] - mt), ei = __expf(bc[t] + m - mt), den = el * denl + ei * qn, inv = 1.0f / fmaxf(fabsf(den), __expf(-mt));
        float ss = 0.f;
#pragma unroll
        for (int j2 = 0; j2 < 2; ++j2) { const f32x4 o = (aN[j2][tt] * el + aI[j2][tt] * ei) * inv; aN[j2][tt] = o; ss += (o[0] * o[0] + o[1] * o[1]) + (o[2] * o[2] + o[3] * o[3]); }
        ss += __shfl_xor(ss, 16); ss += __shfl_xor(ss, 32);
        if (lane < 16) RSs[wave * 64 + 16 * tt + lane] = ss; }
    __syncthreads();
#pragma unroll
    for (int tt = 0; tt < 4; ++tt) { const int t = 16 * tt + (lane & 15); float tot = 0.f;
#pragma unroll
        for (int w2 = 0; w2 < 8; ++w2) tot += RSs[w2 * 64 + t];
        const float rs = rsqrtf(tot * (1.0f / 256.0f) + EPS);
#pragma unroll
        for (int j2 = 0; j2 < 2; ++j2) *(LAS f32x4*)(OST + t * 260 + 16 * (2 * wave + j2) + 4 * g4) = aN[j2][tt] * rs; }
    __syncthreads();
    { const f32x4* mn = (const f32x4*)(p.in[I_MNORM] + j * 1024 + c0); const f32x4* sk = (const f32x4*)(p.in[I_MSKIP] + j * 1024 + c0);
      u32x4* dst = (u32x4*)(GP(bf16_t, WS_U) + mix_off(row0 + t_, c0));
#pragma unroll
      for (int c = 0; c < 4; ++c) { const u32x4 xw = xr[c], zw = zq[c]; const f32x4 oa = *(const LAS f32x4*)(OST + t_ * 260 + sg * 32 + 8 * c), ob = *(const LAS f32x4*)(OST + t_ * 260 + sg * 32 + 8 * c + 4), ma = mn[2 * c], mb = mn[2 * c + 1], sa = sk[2 * c], sb = sk[2 * c + 1];
          u32x4 w; w.x = pk2(sigmoid_f(bflo(zw.x)) * (oa[0] * ma[0] + sa[0] * bflo(xw.x)), sigmoid_f(bfhi(zw.x)) * (oa[1] * ma[1] + sa[1] * bfhi(xw.x)));
          w.y = pk2(sigmoid_f(bflo(zw.y)) * (oa[2] * ma[2] + sa[2] * bflo(xw.y)), sigmoid_f(bfhi(zw.y)) * (oa[3] * ma[3] + sa[3] * bfhi(xw.y)));
          w.z = pk2(sigmoid_f(bflo(zw.z)) * (ob[0] * mb[0] + sb[0] * bflo(xw.z)), sigmoid_f(bfhi(zw.z)) * (ob[1] * mb[1] + sb[1] * bfhi(xw.z)));
          w.w = pk2(sigmoid_f(bflo(zw.w)) * (ob[2] * mb[2] + sb[2] * bflo(xw.w)), sigmoid_f(bfhi(zw.w)) * (ob[3] * mb[3] + sb[3] * bfhi(xw.w)));
          dst[c] = w; } }
    __syncthreads();
}

#ifndef PROBE
#define PROBE 0
#endif
enum Phase { PH_INIT = 0, PH_FFN1, PH_FFN2, PH_FNORM, PH_MIN, PH_E2, PH_E3, PH_E4, PH_O2, PH_O3, PH_O4, PH_O5, PH_MOUT, PH_MNORM };

template <int PH> __device__ __forceinline__ void run_phase(const KP& p, int l, int s, LAS unsigned char* lds, const bool DRY = false) {
    const int j = l >> 1, G = gridDim.x, blk = obid();
    const float* ng = p.in[I_NORMG] + (size_t)l * 6 * DM;
    if constexpr (PH == PH_INIT) {
        if (!(PROBE == 18 && DRY)) ph_norm0(p.in[I_X], GP(bf16_t, WS_XB), GP(float, WS_RS));
        if (!(PROBE == 19 && DRY)) ph_weights_part(p, 0, 0, lds);
    } else if constexpr (PH == PH_FFN1) {
        const int hf = s >> 1, ss = s & 1; constexpr int MH = M / FFN_SPLIT;
        pg8::Gemm g{GP(const bf16_t, WS_XB) + (size_t)hf * MH * DM, GP(const bf16_t, ss ? WS_W1B : WS_W1A), MH, 2 * DFF, DM}; pg8::StaticOrder S; S.init(MH, 2 * DFF, G, blk, WGM_FFN1);
        pg8::EpiSwiglu E{GP(bf16_t, WS_HB) + (size_t)hf * MH * DFF, DFF, GP(const float, WS_RS) + (size_t)hf * MH};
        pg8::gemm_phase<pg8::EpiSwiglu, pg8::StaticOrder, true, true, true, true>(lds, g, S, E);
    } else if constexpr (PH == PH_FFN2) {
        const int hf = s >> 1, ss = s & 1; constexpr int MH = M / FFN_SPLIT;
        pg8::Gemm g{GP(const bf16_t, WS_HB) + (size_t)hf * MH * DFF, GP(const bf16_t, ss ? WS_W2B : WS_W2A), MH, DM, DFF}; pg8::StaticOrder S; S.init(MH, DM, G, blk, WGM_FFN2);
        pg8::EpiBf16P E{GP(bf16_t, WS_HO) + (size_t)hf * MH * DM, DM, nullptr};
        pg8::gemm_phase<pg8::EpiBf16P, pg8::StaticOrder, true, true, true, true>(lds, g, S, E);
    } else if constexpr (PH == PH_FNORM) {
        const float* ga = ng + (s ? 5 : 1) * DM; const bool last = (s == 1 && l == DEPTH - 1);
        ph_norm(GP(const bf16_t, WS_XB), GP(const bf16_t, WS_HO), 0.5f, ga, (last || DRY) ? nullptr : GP(bf16_t, WS_XB), (last && !DRY) ? p.out : nullptr, GP(float, WS_RS));
        if (s == 1 && l + 1 < DEPTH) ph_weights_drain(p, l + 1, 0, lds);
    } else if constexpr (PH == PH_MIN) {
        const int N = (l & 1) ? OD_N : EV_NP;
        pg8::Gemm g{GP(const bf16_t, WS_XB), GP(const bf16_t, WS_WIN), M, N, DM}; pg8::StaticOrder S; S.init(M, N, G, blk, WGM_MIN);
        pg8::EpiBf16P E{GP(bf16_t, WS_HB), N, GP(const float, WS_RS)};
        pg8::gemm_phase<pg8::EpiBf16P, pg8::StaticOrder, true, true, true, true>(lds, g, S, E);
    } else if constexpr (PH == PH_E2) {
        if (!(PROBE == 22 && DRY) && blk < BATCH * NCH * 4) { GlaUC C; GlaUPre pre; int ch = blk & 3; gla_u_consts(p, C, j, ch, otid()); gla_u_load(p, pre, blk >> 9, (blk >> 2) & 127, ch, otid());
            for (int u = blk; u < BATCH * NCH * 4; u += G) { const int u2 = u + G; if ((u & 3) != ch) { ch = u & 3; gla_u_consts(p, C, j, ch, otid()); }
                gla_u_unit(p, C, u >> 9, (u >> 2) & 127, u & 3, lds, pre, u2 < BATCH * NCH * 4, u2 >> 9, (u2 >> 2) & 127, u2 & 3); } }
        if (!(PROBE == 21 && DRY) && blk < BATCH * NCH * 8) { LruC C; LruPre pre; int chd = blk & 7; lru_local_consts(p, C, j, chd, otid()); lru_local_load(p, pre, blk >> 10, (blk >> 3) & 127, chd, otid());
            for (int u = blk; u < BATCH * NCH * 8; u += G) { const int u2 = u + G; if ((u & 7) != chd) { chd = u & 7; lru_local_consts(p, C, j, chd, otid()); }
                lru_local_unit(p, C, u >> 10, (u >> 3) & 127, u & 7, lds, pre, u2 < BATCH * NCH * 8, u2 >> 10, (u2 >> 3) & 127, u2 & 7); } }
    } else if constexpr (PH == PH_E3) {
        if (!(PROBE == 26 && DRY)) ph_gla_state(p);
        if (!(PROBE == 25 && DRY)) for (int u = blk; u < BATCH * NCH / 2; u += G) lru_fix_unit(p, u >> 6, u & 63, lds);
    } else if constexpr (PH == PH_E4) {
        { TilesGLA pre; if (blk < BATCH * NCH * 4) gla_out_load(p, pre, blk >> 9, (blk >> 2) & 127, blk & 3, otid());
          for (int u = blk; u < BATCH * NCH * 4; u += G) { const int u2 = u + G; gla_out_unit(p, j, u >> 9, (u >> 2) & 127, u & 3, lds, pre, u2 < BATCH * NCH * 4, u2 >> 9, (u2 >> 2) & 127, u2 & 3); } }
        ph_weights_drain(p, l, 1, lds);
    } else if constexpr (PH == PH_O2) {
        for (int u = blk; u < BATCH * NCH; u += G) { const int b = u >> 7, n = u & 127;
            mlstm_tok_unit(p, j, b, n, lds);
            asm volatile("s_waitcnt vmcnt(0)" ::: "memory"); __syncthreads();
            MuPre pre; PoolPre ppre; mlstm_u_load(p, pre, b, n, 0, otid());
            for (int h = 0; h < 4; ++h) mlstm_u_unit(p, b, n, h, lds, pre, ppre);
            for (int g = 0; g < 4; ++g) pool_unit(p, j, b, n, g, lds, ppre); }
    } else if constexpr (PH == PH_O3) {
    } else if constexpr (PH == PH_O4) {
        ph_mlstm_state(p);
    } else if constexpr (PH == PH_O5) {
        { TilesML pre; if (blk < BATCH * NCH * 4) mlstm_out_load(p, pre, blk >> 9, (blk >> 2) & 127, blk & 3, otid());
          for (int u = blk; u < BATCH * NCH * 4; u += G) { const int u2 = u + G; mlstm_out_unit(p, j, u >> 9, (u >> 2) & 127, u & 3, lds, pre, u2 < BATCH * NCH * 4, u2 >> 9, (u2 >> 2) & 127, u2 & 3); } }
        ph_weights_drain(p, l, 1, lds);
    } else if constexpr (PH == PH_MOUT) {
        pg8::Gemm g{GP(const bf16_t, WS_U), GP(const bf16_t, WS_WOUT), M, DM, DM}; pg8::StaticOrder S; S.init(M, DM, G, blk, WGM_MOUT);
        pg8::EpiBf16P E{GP(bf16_t, WS_HO), DM, nullptr};
        pg8::gemm_phase<pg8::EpiBf16P, pg8::StaticOrder, true, true, true, true>(lds, g, S, E);
    } else if constexpr (PH == PH_MNORM) {
        ph_norm(GP(const bf16_t, WS_XB), GP(const bf16_t, WS_HO), 1.0f, ng + 3 * DM, DRY ? nullptr : GP(bf16_t, WS_XB), nullptr, GP(float, WS_RS));
    }
}


#define XB_TMO      128
#define XB_XCNT(j)  (256  + 64 * (j))
#define XB_XSUB(j)  (1280 + 64 * (j))
#define XB_XGEN(j)  (2304 + 64 * (j))
#define XB_TOP      3328
#define XB_TOPGEN   3392
#define XCD_BAR_WORDS 3456
#define XB_SPIN_CAP (1u << 18)

__device__ __forceinline__ unsigned xb_ld(unsigned* p)              { return __hip_atomic_load(p, __ATOMIC_RELAXED, __HIP_MEMORY_SCOPE_AGENT); }
__device__ __forceinline__ unsigned xb_add(unsigned* p, unsigned v) { return __hip_atomic_fetch_add(p, v, __ATOMIC_RELAXED, __HIP_MEMORY_SCOPE_AGENT); }
__device__ __forceinline__ unsigned xb_xcc_id() { return (unsigned)__builtin_amdgcn_s_getreg((3 << 11) | 20) & 0xFu; }
#define XB_SPIN(cond, bar) do { unsigned _sp = 0; while (cond) { __builtin_amdgcn_s_sleep(1); \
    if ((++_sp & 255u) == 0u) { if (xb_ld(&(bar)[XB_TMO])) break; if (_sp > XB_SPIN_CAP) { atomicAdd(&(bar)[XB_TMO], 1u); break; } } } } while (0)

struct XcdBarrier {
    unsigned* bar; unsigned x;
    volatile LAS unsigned* st;
};

__device__ __forceinline__ XcdBarrier xcd_barrier_post(unsigned* bar, volatile LAS unsigned* st) {
    XcdBarrier b; b.bar = bar; b.x = xb_xcc_id(); b.st = st;
    if (threadIdx.x == 0) (void)xb_add(&bar[XB_XCNT(b.x)], 1u);
    return b;
}
__device__ __forceinline__ void xcd_barrier_complete(unsigned* bar, unsigned x, unsigned& nloc, unsigned& nx) {
    const unsigned G = gridDim.x * gridDim.y * gridDim.z;
    unsigned sum, cnt, mine, sp = 0u;
    for (;;) {
        sum = 0u; cnt = 0u; mine = 0u;
#pragma unroll
        for (unsigned j = 0; j < 16; ++j) { const unsigned c = xb_ld(&bar[XB_XCNT(j)]); sum += c; cnt += (c > 0u) ? 1u : 0u; mine = (j == x) ? c : mine; }
        if (sum == G) break;
        __builtin_amdgcn_s_sleep(1);
        if ((++sp & 255u) == 0u) { if (xb_ld(&bar[XB_TMO])) break; if (sp > XB_SPIN_CAP) { atomicAdd(&bar[XB_TMO], 1u); break; } }
    }
    nloc = mine > 0u ? mine : 1u; nx = cnt > 0u ? cnt : 1u;
}

__device__ __forceinline__ void xcd_barrier(const XcdBarrier& b) {
    asm volatile("s_waitcnt vmcnt(0)" ::: "memory");
    __syncthreads();
    if (threadIdx.x == 0) {
        unsigned* bar = b.bar;
        __builtin_amdgcn_s_waitcnt(0);
        unsigned nloc = b.st[0], nx = b.st[1];
        if (nloc == 0u) { xcd_barrier_complete(bar, b.x, nloc, nx); b.st[0] = nloc; b.st[1] = nx; }
        const unsigned old = xb_add(&bar[XB_XSUB(b.x)], 1u);
        const unsigned gen = old / nloc;
        if (old + 1u == (gen + 1u) * nloc) {
            __builtin_amdgcn_fence(__ATOMIC_RELEASE, "agent");
            asm volatile("s_waitcnt vmcnt(0)" ::: "memory");
            const unsigned og = xb_add(&bar[XB_TOP], 1u);
            const unsigned tg = og / nx;
            if (og + 1u == (tg + 1u) * nx) xb_add(&bar[XB_TOPGEN], 1u);
            else XB_SPIN(xb_ld(&bar[XB_TOPGEN]) == tg, bar);
            __builtin_amdgcn_fence(__ATOMIC_ACQUIRE, "agent");
            xb_add(&bar[XB_XGEN(b.x)], 1u);
            asm volatile("s_waitcnt vmcnt(0)" ::: "memory");
        } else {
            XB_SPIN(xb_ld(&bar[XB_XGEN(b.x)]) == gen, bar);
            __builtin_amdgcn_fence(__ATOMIC_ACQUIRE, "agent");
            asm volatile("s_waitcnt vmcnt(0)" ::: "memory");
        }
    }
    __syncthreads();
}


__device__ __forceinline__ void xcd_barrier_fill(const XcdBarrier& b, const KP& p, int ql, int qpart, LAS unsigned char* lds) {
    asm volatile("s_waitcnt vmcnt(0)" ::: "memory");
    __syncthreads();
    if (threadIdx.x == 0) {
        unsigned* bar = b.bar;
        __builtin_amdgcn_s_waitcnt(0);
        unsigned nloc = b.st[0], nx = b.st[1];
        if (nloc == 0u) { xcd_barrier_complete(bar, b.x, nloc, nx); b.st[0] = nloc; b.st[1] = nx; }
        const unsigned old = xb_add(&bar[XB_XSUB(b.x)], 1u);
        const unsigned gen = old / nloc;
        if (old + 1u == (gen + 1u) * nloc) {
            __builtin_amdgcn_fence(__ATOMIC_RELEASE, "agent");
            asm volatile("s_waitcnt vmcnt(0)" ::: "memory");
            const unsigned og = xb_add(&bar[XB_TOP], 1u);
            const unsigned tg = og / nx;
            if (og + 1u == (tg + 1u) * nx) xb_add(&bar[XB_TOPGEN], 1u);
            else XB_SPIN(xb_ld(&bar[XB_TOPGEN]) == tg, bar);
            __builtin_amdgcn_fence(__ATOMIC_ACQUIRE, "agent");
            xb_add(&bar[XB_XGEN(b.x)], 1u);
            asm volatile("s_waitcnt vmcnt(0)" ::: "memory");
            b.st[2] = 0xFFFFFFFFu;
        } else b.st[2] = gen;
    }
    __syncthreads();
    const unsigned gen = b.st[2];
    if (gen != 0xFFFFFFFFu) {
        unsigned* xgen = &b.bar[XB_XGEN(b.x)];
        for (;;) {
            if ((unsigned)__builtin_amdgcn_readfirstlane((int)xb_ld(xgen)) != gen) break;
            if (!fill_step(p, ql, qpart, lds)) break;
        }
        if (threadIdx.x == 0) {
            XB_SPIN(xb_ld(xgen) == gen, b.bar);
            __builtin_amdgcn_fence(__ATOMIC_ACQUIRE, "agent");
            asm volatile("s_waitcnt vmcnt(0)" ::: "memory");
        }
    }
    __syncthreads();
}
constexpr int CW_BAR = 1024;
constexpr size_t CTL_ZERO_BYTES = 65536;
__global__ void __launch_bounds__(NTHREADS, 2) k_mega(KP p) {
    extern __shared__ __attribute__((aligned(16))) unsigned char smem[];
    LAS unsigned char* lds = (LAS unsigned char*)smem;
    volatile LAS unsigned* xbw = (volatile LAS unsigned*)(lds + LDS_BYTES - 16);
    if (threadIdx.x < 4) xbw[threadIdx.x] = 0u;
    __syncthreads();
    const XcdBarrier bar = xcd_barrier_post((unsigned*)(p.ws + WS_CTL) + CW_BAR, xbw);
#define PROBE_HIT(PH) ((PROBE == 1 && (PH == PH_FFN1 || PH == PH_FFN2 || PH == PH_MIN || PH == PH_MOUT)) || (PROBE == 2 && (PH == PH_INIT || PH == PH_FNORM || PH == PH_MNORM)) || \
    (PROBE == 3 && (PH == PH_E2 || PH == PH_E4 || PH == PH_O2 || PH == PH_O3 || PH == PH_O5)) || (PROBE == 4 && (PH == PH_E3 || PH == PH_O4)) || (PROBE == 5 && PH == PH_FFN1) || (PROBE == 6 && PH == PH_FFN2) || ((PROBE == 7 || PROBE == 21 || PROBE == 22) && PH == PH_E2) || (PROBE == 8 && PH == PH_E4) || (PROBE == 9 && PH == PH_O2) || ((PROBE == 10 || PROBE == 23 || PROBE == 24) && PH == PH_O3) || (PROBE == 11 && PH == PH_O5) || \
    (PROBE == 12 && PH == PH_MIN) || (PROBE == 13 && PH == PH_MOUT) || ((PROBE == 14 || PROBE == 18 || PROBE == 19) && PH == PH_INIT) || (PROBE == 15 && PH == PH_MNORM) || ((PROBE == 16 || PROBE == 25 || PROBE == 26) && PH == PH_E3) || (PROBE == 17 && PH == PH_O4))
#define xcd_barrier(b) do { XcdBarrier b_ = (b); asm volatile("" : "+s"(b_.x)); asm volatile("" : "+s"(b_.bar)); xcd_barrier(b_); if (PROBE == 20) xcd_barrier(b_); } while (0)
#define xcd_barrier_q(b, ql_, qp_) do { XcdBarrier b_ = (b); asm volatile("" : "+s"(b_.x)); asm volatile("" : "+s"(b_.bar)); xcd_barrier_fill(b_, p, ql_, qp_, lds); } while (0)
#define RUNP(PH, l_, s_) do { for (int rep_ = PROBE_HIT(PH) ? 0 : 1; rep_ < 2; ++rep_) { run_phase<PH>(p, l_, s_, lds, rep_ == 0); if (rep_ == 0) xcd_barrier(bar); } } while (0)
    RUNP(PH_INIT, 0, 0); xcd_barrier(bar);
    for (int l = 0; l < DEPTH; ++l) {
        for (int sub = 0; sub < 3; ++sub) {
            if (sub != 1) { const int s = sub >> 1;
                for (int hf = 0; hf < FFN_SPLIT; ++hf) {
                    RUNP(PH_FFN1, l, s + 2 * hf); xcd_barrier_q(bar, s == 0 ? l : l + 1, s == 0 ? 1 : 0);
                    RUNP(PH_FFN2, l, s + 2 * hf); xcd_barrier_q(bar, s == 0 ? l : l + 1, s == 0 ? 1 : 0);
                }
                RUNP(PH_FNORM, l, s); if (!(l == DEPTH - 1 && s == 1)) xcd_barrier(bar);
            } else {
                RUNP(PH_MIN, l, 0); xcd_barrier_q(bar, l, 1);
                if ((l & 1) == 0) {
                    RUNP(PH_E2, l, 0); xcd_barrier(bar);
                    RUNP(PH_E3, l, 0); xcd_barrier(bar);
                    RUNP(PH_E4, l, 0); xcd_barrier(bar);
                } else {
                    RUNP(PH_O2, l, 0); xcd_barrier(bar);
                    RUNP(PH_O4, l, 0); xcd_barrier(bar);
                    RUNP(PH_O5, l, 0); xcd_barrier(bar);
                }
                RUNP(PH_MOUT, l, 0); xcd_barrier_q(bar, l + 1, 0);
                RUNP(PH_MNORM, l, 0); xcd_barrier(bar);
            }
        }
    }
}

#ifndef MK_MULTI
#define MK_MULTI 0
#endif
template <int PH> __global__ void __launch_bounds__(NTHREADS, 2) k_phase(KP p, int l, int s) {
    extern __shared__ __attribute__((aligned(16))) unsigned char smem[];
    run_phase<PH>(p, l, s, (LAS unsigned char*)smem);
}

template <int PH> static void launch_phase(const KP& p, int l, int s, hipStream_t st) {
    static bool attr = false;
    if (!attr) { (void)hipFuncSetAttribute((const void*)k_phase<PH>, hipFuncAttributeMaxDynamicSharedMemorySize, LDS_BYTES); attr = true; }
    hipLaunchKernelGGL((k_phase<PH>), dim3(256), dim3(NTHREADS), LDS_BYTES, st, p, l, s);
}

extern "C" void kernel_launch(void* const* d_in, const int* in_sizes, int n_in, void* d_out, int out_size, void* d_ws, size_t ws_size, hipStream_t stream) {
    if (n_in != 30 || ws_size < WS_END) { fprintf(stderr, "kernel_launch: unexpected n_in %d or ws_size %zu (< %zu)\n", n_in, ws_size, (size_t)WS_END); return; }
    KP p{};
    for (int i = 0; i < 30; ++i) p.in[i] = (const float*)d_in[i];
    p.out = (float*)d_out; p.ws = (unsigned char*)d_ws;
#if MK_MULTI
    launch_phase<PH_INIT>(p, 0, 0, stream);
    for (int l = 0; l < DEPTH; ++l) {
        for (int hf = 0; hf < FFN_SPLIT; ++hf) { launch_phase<PH_FFN1>(p, l, 2 * hf, stream); launch_phase<PH_FFN2>(p, l, 2 * hf, stream); } launch_phase<PH_FNORM>(p, l, 0, stream);
        launch_phase<PH_MIN>(p, l, 0, stream);
        if ((l & 1) == 0) { launch_phase<PH_E2>(p, l, 0, stream); launch_phase<PH_E3>(p, l, 0, stream); launch_phase<PH_E4>(p, l, 0, stream); }
        else { launch_phase<PH_O2>(p, l, 0, stream); launch_phase<PH_O3>(p, l, 0, stream); launch_phase<PH_O4>(p, l, 0, stream); launch_phase<PH_O5>(p, l, 0, stream); }
        launch_phase<PH_MOUT>(p, l, 0, stream); launch_phase<PH_MNORM>(p, l, 0, stream);
        for (int hf = 0; hf < FFN_SPLIT; ++hf) { launch_phase<PH_FFN1>(p, l, 1 + 2 * hf, stream); launch_phase<PH_FFN2>(p, l, 1 + 2 * hf, stream); } launch_phase<PH_FNORM>(p, l, 1, stream);
    }
#else
    static int grid = 0;
    if (grid == 0) {
        int dev = 0, cus = 0, per_cu = 0;
        if (hipGetDevice(&dev) != hipSuccess || hipDeviceGetAttribute(&cus, hipDeviceAttributeMultiprocessorCount, dev) != hipSuccess) { fprintf(stderr, "kernel_launch: device query failed\n"); grid = -1; return; }
        if (hipFuncSetAttribute((const void*)k_mega, hipFuncAttributeMaxDynamicSharedMemorySize, LDS_BYTES) != hipSuccess) { fprintf(stderr, "kernel_launch: hipFuncSetAttribute failed\n"); grid = -1; return; }
        if (hipOccupancyMaxActiveBlocksPerMultiprocessor(&per_cu, (const void*)k_mega, NTHREADS, LDS_BYTES) != hipSuccess || per_cu < 1) { fprintf(stderr, "kernel_launch: occupancy query says %d blocks per CU\n", per_cu); per_cu = 1; }
        (void)hipGetLastError();
        grid = cus;
    }
    if (grid < 0) return;
    if (hipMemsetAsync((char*)d_ws + WS_CTL, 0, CTL_ZERO_BYTES, stream) != hipSuccess) { fprintf(stderr, "kernel_launch: memset failed\n"); return; }
    hipLaunchKernelGGL(k_mega, dim3(grid), dim3(NTHREADS), LDS_BYTES, stream, p);
#endif
}
```

```cpp
#include <hip/hip_runtime.h>
#include <cstdio>
#include <cstdint>
__device__ __forceinline__ int otid() { int t = (int)threadIdx.x; asm volatile("" : "+v"(t)); return t; }
__device__ __forceinline__ int obid() { int b = (int)blockIdx.x; asm volatile("" : "+s"(b)); return b; }
namespace pg8 {
#define PG8_LAS __attribute__((address_space(3)))
typedef unsigned short bf16_t;
typedef short bf16x8 __attribute__((ext_vector_type(8)));
typedef float f32x4 __attribute__((ext_vector_type(4)));
typedef unsigned u32x4 __attribute__((ext_vector_type(4)));
constexpr int BM = 256, BK = 64, HALF = 128, HTB = HALF * BK * 2  , STAGE_BYTES = 8 * HTB, NXCD = 8, WGM = 4;

__host__ __device__ __forceinline__ int lds_byte(int r, int c) { const int st = (r >> 4) * 2 + (c >> 5), rr = r & 15, cc = c & 31, ob = rr * 64 + cc * 2; return st * 1024 + (ob ^ (((ob >> 9) & 1) << 5)); }
__host__ __device__ __forceinline__ void stage_rc(int b, int& R, int& C) { const int st = b / 1024, sb = b % 1024, swz = sb ^ (((sb >> 9) & 1) << 5); R = (st >> 1) * 16 + swz / 64; C = (st & 1) * 32 + (swz % 64) / 2; }
__host__ __device__ __forceinline__ int perm32(int rho) { const int n = rho >> 4, i = rho & 15; return 8 * (i >> 2) + 4 * n + (i & 3); }

struct Unit { int pm, pn; };
struct Gemm { const bf16_t* A; const bf16_t* Bt; int M, N, K; };

struct StaticOrder {
    int nM, nN, nwg, G, c, wgm;
    __host__ __device__ void init(int M, int N, int G_, int c_, int wgm_ = WGM) { nM = M / BM; nN = N / BM; nwg = nM * nN; G = G_; c = c_; wgm = wgm_; }
    __host__ __device__ bool next(int i, Unit& u) const {
        const long L = (long)i * G + c; if (L >= nwg) return false;
        int wgid = (int)L; { const int q = nwg / NXCD, r = nwg % NXCD, xcd = wgid % NXCD, off = wgid / NXCD; wgid = (xcd < r ? xcd * (q + 1) : r * (q + 1) + (xcd - r) * q) + off; }
        const int nig = wgm * nN, gid = wgid / nig, fm = gid * wgm, gsz = (nM - fm) < wgm ? (nM - fm) : wgm;
        u.pm = fm + ((wgid % nig) % gsz); u.pn = (wgid % nig) / gsz; return true;
    }
    __device__ __forceinline__ void a_ready(const Unit&) const {}
    __device__ __forceinline__ void done(const Unit&) const {}
};

typedef __bf16 hwbf2_t __attribute__((ext_vector_type(2)));
typedef float hwf2_t __attribute__((ext_vector_type(2)));
__device__ __forceinline__ unsigned cvt_pk_bf16(float lo, float hi) { const hwf2_t v = {lo, hi}; return __builtin_bit_cast(unsigned, __builtin_convertvector(v, hwbf2_t)); }
typedef float f32x2 __attribute__((ext_vector_type(2)));
__device__ __forceinline__ float silu_f(float x) { return x * __builtin_amdgcn_rcpf(1.0f + __expf(-x)); }
struct EpiSwiglu {
    static constexpr bool PERM = true, AFTER_DRAIN = false;
    bf16_t* O; int ldc; const float* rs;
    __device__ __forceinline__ void stage(const Unit& u, PG8_LAS unsigned char* area, int wr, int lane) const {
        const float* src = rs + u.pm * BM + wr * 64 + lane;
        __builtin_amdgcn_global_load_lds((const unsigned*)src, (PG8_LAS unsigned*)area, 4, 0, 0);
        __builtin_amdgcn_global_load_lds((const unsigned*)(src + HALF), (PG8_LAS unsigned*)(area + 256), 4, 0, 0);
    }
    __device__ __forceinline__ void operator()(const f32x4 (&acc)[2][2][4][2], const Unit& u, int wr, int wc, int fr, int fq, const PG8_LAS unsigned char* area) const {
        const int row0 = u.pm * BM + wr * 64 + fr, col0 = u.pn * HALF + wc * 32 + 8 * fq; (void)row0;
        bf16_t* const obase = O + (((size_t)u.pm * (ldc / BK) + 2 * u.pn + (wc >> 1)) * BM + wr * 64 + fr) * BK + (wc & 1) * 32 + 8 * fq;
        float rsv[2][4];
#pragma unroll
        for (int ai = 0; ai < 2; ++ai)
#pragma unroll
            for (int m = 0; m < 4; ++m) rsv[ai][m] = *(const PG8_LAS float*)(area + ai * 256 + (m * 16 + fr) * 4);
#pragma unroll
        for (int ai = 0; ai < 2; ++ai)
#pragma unroll
            for (int m = 0; m < 4; ++m) { bf16_t* rowp = obase + (ai * HALF + m * 16) * BK; const float r_ = rsv[ai][m], r2 = r_ * -1.4426950408889634f, rr = r_ * r_;
                const f32x4 t0 = acc[ai][0][m][0] * r2, t1 = acc[ai][0][m][1] * r2;
                f32x4 d0, d1, q0, q1;
#pragma unroll
                for (int i = 0; i < 4; ++i) { d0[i] = __builtin_amdgcn_exp2f(t0[i]); d1[i] = __builtin_amdgcn_exp2f(t1[i]); }
                d0 = d0 + 1.0f; d1 = d1 + 1.0f;
#pragma unroll
                for (int i = 0; i < 4; ++i) { q0[i] = __builtin_amdgcn_rcpf(d0[i]); q1[i] = __builtin_amdgcn_rcpf(d1[i]); }
                const f32x4 o0 = (acc[ai][0][m][0] * acc[ai][1][m][0]) * rr * q0, o1 = (acc[ai][0][m][1] * acc[ai][1][m][1]) * rr * q1;
                u32x4 w; w.x = cvt_pk_bf16(o0[0], o0[1]); w.y = cvt_pk_bf16(o0[2], o0[3]); w.z = cvt_pk_bf16(o1[0], o1[1]); w.w = cvt_pk_bf16(o1[2], o1[3]);
                *(u32x4*)rowp = w; }
    }
};
struct EpiBf16P {
    static constexpr bool PERM = true, AFTER_DRAIN = false;
    bf16_t* O; int ldc; const float* rs;
    __device__ __forceinline__ void stage(const Unit& u, PG8_LAS unsigned char* area, int wr, int lane) const {
        if (rs) { const float* src = rs + u.pm * BM + wr * 64 + lane;
            __builtin_amdgcn_global_load_lds((const unsigned*)src, (PG8_LAS unsigned*)area, 4, 0, 0);
            __builtin_amdgcn_global_load_lds((const unsigned*)(src + HALF), (PG8_LAS unsigned*)(area + 256), 4, 0, 0); }
    }
    __device__ __forceinline__ void operator()(const f32x4 (&acc)[2][2][4][2], const Unit& u, int wr, int wc, int fr, int fq, const PG8_LAS unsigned char* area) const {
        const int row0 = u.pm * BM + wr * 64 + fr, col0 = u.pn * BM + wc * 32 + 8 * fq;
        float rsv[2][4];
#pragma unroll
        for (int ai = 0; ai < 2; ++ai)
#pragma unroll
            for (int m = 0; m < 4; ++m) rsv[ai][m] = rs ? *(const PG8_LAS float*)(area + ai * 256 + (m * 16 + fr) * 4) : 1.0f;
#pragma unroll
        for (int ai = 0; ai < 2; ++ai)
#pragma unroll
            for (int m = 0; m < 4; ++m) { bf16_t* rowp = O + (size_t)(row0 + ai * HALF + m * 16) * ldc + col0; const float r_ = rsv[ai][m];
#pragma unroll
                for (int bj = 0; bj < 2; ++bj) { const f32x4 v0 = acc[ai][bj][m][0] * r_, v1 = acc[ai][bj][m][1] * r_;
                    u32x4 w; w.x = cvt_pk_bf16(v0[0], v0[1]); w.y = cvt_pk_bf16(v0[2], v0[3]); w.z = cvt_pk_bf16(v1[0], v1[1]); w.w = cvt_pk_bf16(v1[2], v1[3]);
                    *(u32x4*)(rowp + bj * HALF) = w; } }
    }
};

template <class Epi, class Sched, bool ALIGN_EPI = false, bool SP2 = false, bool ABLK = false, bool BBLK = false>
__device__ __forceinline__ void gemm_phase(PG8_LAS unsigned char* lds, const Gemm g, const Sched& S, const Epi& E) {
    const int tid = otid(), wid = __builtin_amdgcn_readfirstlane(tid >> 6), lane = tid & 63, wr = wid >> 2, wc = wid & 3, fr = lane & 15, fq = lane >> 4;
    const int K = g.K, nt = K / BK;
    unsigned voffA[2], voffB[2];
#pragma unroll
    for (int i = 0; i < 2; ++i) { int R, C; stage_rc(tid * 16 + i * 8192, R, C); const int Rb = Epi::PERM ? ((R & ~31) + perm32(R & 31)) : R;
        voffA[i] = ABLK ? (unsigned)(R * BK + C) * 2u : (unsigned)(R * K + C) * 2u; voffB[i] = BBLK ? (unsigned)(Rb * BK + C) * 2u : (unsigned)(Rb * K + C) * 2u; }
    const size_t kstepB = BBLK ? (size_t)BM * BK * 2 : (size_t)(BK * 2), kstepA = ABLK ? (size_t)BM * BK * 2 : (size_t)(BK * 2);
    const size_t hstepB = BBLK ? (size_t)HALF * BK * 2 : (size_t)HALF * K * 2, hstepA = ABLK ? (size_t)HALF * BK * 2 : (size_t)HALF * K * 2;
    const size_t tstep = (size_t)BM * K * 2;
    const unsigned ldsw = (unsigned)wid * 1024u;
    const int aoff = lds_byte(wr * 64 + fr, fq * 8), boff = lds_byte(wc * 32 + fr, fq * 8);
#define PG8_SA(b, h) (((b) * 2 + (h)) * HTB)
#define PG8_SB(b, h) ((4 + (b) * 2 + (h)) * HTB)
#define PG8_STAGE(bufoff, gbase, voff) do { _Pragma("unroll") for (int _i = 0; _i < 2; ++_i) \
        __builtin_amdgcn_global_load_lds((const unsigned*)((const char*)(gbase) + (voff)[_i]), (PG8_LAS unsigned*)(lds + (bufoff) + ldsw + _i * 8192), 16, 0, 0); } while (0)
#define PG8_LDA(dst, b, h) do { _Pragma("unroll") for (int m = 0; m < 4; ++m) _Pragma("unroll") for (int k = 0; k < 2; ++k) dst[m][k] = *(const PG8_LAS bf16x8*)(lds + PG8_SA(b, h) + aoff + m * 2048 + k * 1024); } while (0)
#define PG8_LDB(dst, b, h) do { _Pragma("unroll") for (int n = 0; n < 2; ++n) _Pragma("unroll") for (int k = 0; k < 2; ++k) dst[n][k] = *(const PG8_LAS bf16x8*)(lds + PG8_SB(b, h) + boff + n * 2048 + k * 1024); } while (0)
#define PG8_MMA(ai, bj, At, Bt) do { __builtin_amdgcn_s_setprio(1); _Pragma("unroll") for (int m = 0; m < 4; ++m) _Pragma("unroll") for (int n = 0; n < 2; ++n) _Pragma("unroll") for (int k = 0; k < 2; ++k) \
        acc[ai][bj][m][n] = __builtin_amdgcn_mfma_f32_16x16x32_bf16(Bt[n][k], At[m][k], acc[ai][bj][m][n], 0, 0, 0); __builtin_amdgcn_s_setprio(0); } while (0)
#define PG8_WAIT_V(n) asm volatile("s_waitcnt vmcnt(" #n ")" ::: "memory")
#define PG8_WAIT_L(n) asm volatile("s_waitcnt lgkmcnt(" #n ")" ::: "memory")
#define PG8_BAR __builtin_amdgcn_s_barrier()
#define PG8_SCHED __builtin_amdgcn_sched_barrier(0)
    Unit cur, nxt; int ui = 0;
    if (!S.next(0, cur)) return;
    f32x4 acc[2][2][4][2];
#pragma unroll
    for (int a = 0; a < 2; ++a)
#pragma unroll
        for (int b = 0; b < 2; ++b)
#pragma unroll
            for (int m = 0; m < 4; ++m)
#pragma unroll
                for (int n = 0; n < 2; ++n) acc[a][b][m][n] = (f32x4){0.f, 0.f, 0.f, 0.f};
    bf16x8 At[4][2], B0[2][2], B1[2][2];
    const char* cA = (const char*)g.A + (size_t)cur.pm * tstep; const char* cB = (const char*)g.Bt + (size_t)cur.pn * tstep;
    S.a_ready(cur);
    if constexpr (SP2) {
        PG8_STAGE(PG8_SB(0, 0), cB, voffB); PG8_STAGE(PG8_SB(0, 1), cB + hstepB, voffB); PG8_STAGE(PG8_SA(0, 0), cA, voffA); PG8_STAGE(PG8_SA(0, 1), cA + hstepA, voffA);
        if (wr == 1) PG8_BAR;
        PG8_WAIT_V(2); PG8_BAR;
        PG8_STAGE(PG8_SB(1, 0), cB + kstepB, voffB); PG8_STAGE(PG8_SA(1, 0), cA + kstepA, voffA); PG8_STAGE(PG8_SB(1, 1), cB + hstepB + kstepB, voffB);
        PG8_WAIT_V(6); PG8_BAR;
    } else {
        PG8_STAGE(PG8_SB(0, 0), cB, voffB); PG8_STAGE(PG8_SA(0, 0), cA, voffA); PG8_STAGE(PG8_SB(0, 1), cB + hstepB, voffB); PG8_STAGE(PG8_SA(0, 1), cA + hstepA, voffA);
        if (wr == 1) PG8_BAR;
        PG8_WAIT_V(4); PG8_BAR;
        PG8_STAGE(PG8_SB(1, 0), cB + kstepB, voffB); PG8_STAGE(PG8_SA(1, 0), cA + kstepA, voffA); PG8_STAGE(PG8_SB(1, 1), cB + hstepB + kstepB, voffB);
        PG8_WAIT_V(6); PG8_BAR;
    }
    for (;;) {
        const bool has_next = S.next(ui + 1, nxt);
        PG8_LAS unsigned char* const rs_area = lds + STAGE_BYTES + wid * 512;
        E.stage(cur, rs_area, wr, lane);
        const char* nA = has_next ? (const char*)g.A + (size_t)nxt.pm * tstep : cA; const char* nB = has_next ? (const char*)g.Bt + (size_t)nxt.pn * tstep : cB;
        for (int t = 0; t < nt; t += 2) {
            const bool last = (t == nt - 2);
            const char* a1 = cA + (size_t)(t + 1) * kstepA;
            const char* a2 = last ? nA : cA + (size_t)(t + 2) * kstepA; const char* b2 = last ? nB : cB + (size_t)(t + 2) * kstepB;
            const char* a3 = a2 + kstepA; const char* b3 = b2 + kstepB;
            if (last && has_next) S.a_ready(nxt);
            if constexpr (SP2) {
            PG8_LDB(B0, 0, 0); PG8_LDB(B1, 0, 1); PG8_SCHED; PG8_LDA(At, 0, 0); PG8_STAGE(PG8_SA(1, 1), a1 + hstepA, voffA);
            PG8_WAIT_V(8); PG8_WAIT_L(0); PG8_BAR; PG8_MMA(0, 0, At, B0); PG8_MMA(0, 1, At, B1); PG8_BAR; PG8_SCHED;
            PG8_LDA(At, 0, 1); PG8_STAGE(PG8_SB(0, 0), b2, voffB); PG8_STAGE(PG8_SB(0, 1), b2 + hstepB, voffB); PG8_STAGE(PG8_SA(0, 0), a2, voffA);
            PG8_WAIT_V(8); PG8_WAIT_L(0); PG8_BAR; PG8_MMA(1, 0, At, B0); PG8_MMA(1, 1, At, B1); PG8_BAR; PG8_SCHED;
            PG8_LDB(B0, 1, 0); PG8_LDB(B1, 1, 1); PG8_SCHED; PG8_LDA(At, 1, 0); PG8_STAGE(PG8_SA(0, 1), a2 + hstepA, voffA);
            PG8_WAIT_V(8); PG8_WAIT_L(0); PG8_BAR; PG8_MMA(0, 0, At, B0); PG8_MMA(0, 1, At, B1); PG8_BAR; PG8_SCHED;
            PG8_LDA(At, 1, 1); PG8_STAGE(PG8_SB(1, 0), b3, voffB); PG8_STAGE(PG8_SB(1, 1), b3 + hstepB, voffB); PG8_STAGE(PG8_SA(1, 0), a3, voffA);
            PG8_WAIT_V(8); PG8_WAIT_L(0); PG8_BAR; PG8_MMA(1, 0, At, B0); PG8_MMA(1, 1, At, B1); PG8_BAR; PG8_SCHED;
            } else {
            PG8_LDB(B0, 0, 0); PG8_SCHED; PG8_LDA(At, 0, 0); PG8_STAGE(PG8_SA(1, 1), a1 + hstepA, voffA);
            PG8_WAIT_L(8); PG8_BAR; PG8_WAIT_L(0); PG8_MMA(0, 0, At, B0); PG8_BAR; PG8_SCHED;
            PG8_LDB(B1, 0, 1); PG8_STAGE(PG8_SB(0, 0), b2, voffB);
            PG8_BAR; PG8_WAIT_L(0); PG8_MMA(0, 1, At, B1); PG8_BAR;
            PG8_LDA(At, 0, 1); PG8_STAGE(PG8_SA(0, 0), a2, voffA);
            PG8_BAR; PG8_WAIT_L(0); PG8_MMA(1, 0, At, B0); PG8_BAR; PG8_SCHED;
            PG8_STAGE(PG8_SB(0, 1), b2 + hstepB, voffB);
            PG8_WAIT_V(6); PG8_BAR; PG8_MMA(1, 1, At, B1); PG8_BAR;
            PG8_LDB(B0, 1, 0); PG8_SCHED; PG8_LDA(At, 1, 0); PG8_STAGE(PG8_SA(0, 1), a2 + hstepA, voffA);
            PG8_WAIT_L(8); PG8_BAR; PG8_WAIT_L(0); PG8_MMA(0, 0, At, B0); PG8_BAR; PG8_SCHED;
            PG8_LDB(B1, 1, 1); PG8_STAGE(PG8_SB(1, 0), b3, voffB);
            PG8_BAR; PG8_WAIT_L(0); PG8_MMA(0, 1, At, B1); PG8_BAR;
            PG8_LDA(At, 1, 1); PG8_STAGE(PG8_SA(1, 0), a3, voffA);
            PG8_BAR; PG8_WAIT_L(0); PG8_MMA(1, 0, At, B0); PG8_BAR; PG8_SCHED;
            PG8_STAGE(PG8_SB(1, 1), b3 + hstepB, voffB);
            PG8_WAIT_V(6); PG8_BAR; PG8_MMA(1, 1, At, B1); PG8_BAR;
            }
        }
        if constexpr (ALIGN_EPI) { if (wr == 0) PG8_BAR; }
        if constexpr (!Epi::AFTER_DRAIN) { E(acc, cur, wr, wc, fr, fq, rs_area); S.done(cur); }
        if (!has_next) break;
#pragma unroll
        for (int a = 0; a < 2; ++a)
#pragma unroll
            for (int b = 0; b < 2; ++b)
#pragma unroll
                for (int m = 0; m < 4; ++m)
#pragma unroll
                    for (int n = 0; n < 2; ++n) acc[a][b][m][n] = (f32x4){0.f, 0.f, 0.f, 0.f};
        cur = nxt; cA = nA; cB = nB; ++ui;
        if constexpr (ALIGN_EPI) { if (wr == 1) PG8_BAR; }
    }
    PG8_WAIT_V(0);
    if constexpr (!ALIGN_EPI) { if (wr == 0) PG8_BAR; }
    PG8_BAR;
    if constexpr (Epi::AFTER_DRAIN) { E.fused(acc, cur, wr, wc, fr, fq, lds, wid, lane); S.done(cur); }
#undef PG8_SA
#undef PG8_SB
#undef PG8_STAGE
#undef PG8_LDA
#undef PG8_LDB
#undef PG8_MMA
#undef PG8_WAIT_V
#undef PG8_WAIT_L
#undef PG8_BAR
#undef PG8_SCHED
}
}

#define LAS __attribute__((address_space(3)))
using pg8::bf16_t; using pg8::bf16x8; using pg8::f32x4; using pg8::u32x4;
typedef unsigned u32x2 __attribute__((ext_vector_type(2)));

constexpr int BATCH = 4, SEQ = 8192, DM = 2048, DFF = 5632, M = BATCH * SEQ, NCH = SEQ / 64, DEPTH = 4;
constexpr int EV_N = 5136, EV_NP = 5376, OD_N = 3072;
constexpr float EPS = 1e-6f;
constexpr int NTHREADS = 512, NWAVES = 8, LDS_BYTES = 147456;
#ifndef WGM_FFN1
#define WGM_FFN1 4
#endif
#ifndef WGM_FFN2
#define WGM_FFN2 4
#endif
#ifndef WGM_MIN
#define WGM_MIN 4
#endif
#ifndef WGM_MOUT
#define WGM_MOUT 4
#endif
#ifndef FFN_SPLIT
#define FFN_SPLIT 1
#endif

constexpr size_t MiB = (size_t)1 << 20;
constexpr size_t WS_CTL = 0;
constexpr size_t WS_W1A = 1 * MiB;
constexpr size_t WS_W1B = 45 * MiB;
constexpr size_t WS_W2A = 89 * MiB;
constexpr size_t WS_W2B = 111 * MiB;
constexpr size_t WS_WIN = 133 * MiB;
constexpr size_t WS_WOUT = 154 * MiB;
constexpr size_t WS_WAT = 162 * MiB;
constexpr size_t WS_WXT = WS_WAT + 262144;
constexpr size_t WS_POOLT = WS_WAT + 524288;
constexpr size_t WS_U = 163 * MiB;
constexpr size_t WS_HB = 291 * MiB;
constexpr size_t WS_HO = 643 * MiB;
constexpr size_t WS_MX = WS_HO;
constexpr size_t WS_S = 1290 * MiB;
constexpr size_t WS_XB = 1306 * MiB;
constexpr size_t WS_RS = 1434 * MiB;
constexpr size_t WS_END = 1435 * MiB;
constexpr size_t WS_UG = WS_MX, WS_SS = WS_MX + 256 * MiB, WS_BC = WS_MX + 384 * MiB, WS_HLOC = WS_MX + 448 * MiB, WS_APROD = WS_MX + 512 * MiB;
constexpr size_t WS_UM = WS_MX, WS_CS = WS_MX + 256 * MiB, WS_XC = WS_MX + 512 * MiB, WS_Q = WS_MX + 576 * MiB;
constexpr size_t WS_V = WS_HB + 192 * MiB, WS_KB = WS_HB + 256 * MiB;
constexpr size_t WS_CARA = WS_S, WS_CARH = WS_S + 2 * MiB, WS_DEC = WS_S + 4 * MiB, WS_GATES = WS_S + 5 * MiB, WS_SC = WS_S + 6 * MiB, WS_MS = WS_S + 7 * MiB, WS_NU = WS_S + 8 * MiB, WS_NS = WS_S + 10 * MiB;

enum { I_X = 0, I_NORMG, I_WG, I_WU, I_WD, I_EVIN, I_EVOUT, I_LCW, I_LCB, I_LWA, I_LBA, I_LWX, I_LBX, I_LLAM, I_GWG, I_GBG, I_GNORM,
       I_ODIN, I_ODOUT, I_MCW, I_MCB, I_MWQ, I_MWK, I_MWV, I_MWIF, I_MBIF, I_MSKIP, I_MNORM, I_POOLW, I_POOLS };

struct KP { const float* in[30]; float* out; unsigned char* ws; };
#define GP(T, off) ((T*)(p.ws + (off)))

__device__ __forceinline__ float bf2f(bf16_t b) { return __uint_as_float(((unsigned)b) << 16); }
__device__ __forceinline__ float bflo(unsigned w) { return __uint_as_float(w << 16); }
__device__ __forceinline__ float bfhi(unsigned w) { return __uint_as_float(w & 0xffff0000u); }
typedef __bf16 hwbf2 __attribute__((ext_vector_type(2)));
typedef float hwf2 __attribute__((ext_vector_type(2)));
__device__ __forceinline__ unsigned pk2(float lo, float hi) { const hwf2 v = {lo, hi}; return __builtin_bit_cast(unsigned, __builtin_convertvector(v, hwbf2)); }
__device__ __forceinline__ bf16_t f2bf(float f) { return __builtin_bit_cast(bf16_t, (__bf16)f); }
__device__ __forceinline__ float wave_sum(float v) {
#pragma unroll
    for (int o = 1; o < 64; o <<= 1) v += __shfl_xor(v, o);
    return v;
}
__device__ __forceinline__ float wave_max(float v) {
#pragma unroll
    for (int o = 1; o < 64; o <<= 1) v = fmaxf(v, __shfl_xor(v, o));
    return v;
}
__device__ __forceinline__ float sigmoid_f(float x) { return __builtin_amdgcn_rcpf(1.0f + __expf(-x)); }
__device__ __forceinline__ float logsigmoid_f(float x) { return fminf(x, 0.0f) - __logf(1.0f + __expf(-fabsf(x))); }
__device__ __forceinline__ float one_minus_exp_f(float x) { const float ser = -x * (1.0f + x * (0.5f + x * (0.16666667f + x * (0.041666668f + x * 0.008333334f)))); return x > -0.25f ? ser : 1.0f - __expf(x); }
__device__ __forceinline__ float softplus_neg_f(float lam) { const float x = __expf(-lam), z = x / (2.0f + x), z2 = z * z;
    const float ser = 2.0f * z * (1.0f + z2 * (0.33333334f + z2 * (0.2f + z2 * (0.14285715f + z2 * (0.11111111f + z2 * (0.09090909f + z2 * 0.07692308f))))));
    return x > 1.0f ? __logf(1.0f + x) : ser; }
__device__ __forceinline__ float gelu_tanh_f(float x) { const float y = 0.7978845608028654f * (x + 0.044715f * x * x * x); const float t = 1.0f - 2.0f * __builtin_amdgcn_rcpf(__expf(2.0f * y) + 1.0f); return 0.5f * x * (1.0f + t); }
#define MFMA16(a, b, c) __builtin_amdgcn_mfma_f32_16x16x32_bf16((a), (b), (c), 0, 0, 0)
__device__ __forceinline__ bf16x8 lds_frag(const LAS bf16_t* base, int ld, int r0, int k0, int lane) { return *(const LAS bf16x8*)(base + (r0 + (lane & 15)) * ld + k0 + (lane >> 4) * 8); }
__device__ __forceinline__ bf16x8 glb_frag(const bf16_t* base, int ld, int r0, int k0, int lane) { return *(const bf16x8*)(base + (size_t)(r0 + (lane & 15)) * ld + k0 + (lane >> 4) * 8); }
#define F4ZERO ((f32x4){0.f, 0.f, 0.f, 0.f})
typedef short s16x4 __attribute__((ext_vector_type(4)));
__device__ __forceinline__ bf16x8 tr_frag(const LAS bf16_t* base, int ld, int kA, int kB, int n0, int lane) {
    const int q = (lane >> 2) & 3, pp = lane & 3;
    const s16x4 lo = __builtin_amdgcn_ds_read_tr16_b64_v4i16((LAS s16x4*)(base + (kA + q) * ld + n0 + 4 * pp));
    const s16x4 hi = __builtin_amdgcn_ds_read_tr16_b64_v4i16((LAS s16x4*)(base + (kB + q) * ld + n0 + 4 * pp));
    return __builtin_shufflevector(lo, hi, 0, 1, 2, 3, 4, 5, 6, 7);
}
__device__ __forceinline__ bf16x8 lds_frag_perm(const LAS bf16_t* base, int ld, int r0, int k0, int lane) {
    const LAS bf16_t* pr = base + (r0 + (lane & 15)) * ld + k0 + 4 * (lane >> 4);
    const s16x4 lo = *(const LAS s16x4*)pr, hi = *(const LAS s16x4*)(pr + 16);
    return __builtin_shufflevector(lo, hi, 0, 1, 2, 3, 4, 5, 6, 7);
}

struct WItem { const float* W; bf16_t* WT; const float* gk; int K, N, k0, n0, drow0; bool big; };
__device__ __forceinline__ WItem w_item(const KP& p, int l, int it) {
    const int j = l >> 1; const bool even = (l & 1) == 0;
    constexpr int FI = (DM / 64) * (DFF / 64);
    const int n_in = even ? (DM / 64) * ((EV_N + 63) / 64) : (DM / 64) * (OD_N / 64), n_out = (DM / 64) * (DM / 64);
    WItem w; w.gk = nullptr; w.big = true; int mode = 0, r;
    if (it < 6 * FI) { const int mtx = it / FI; r = it % FI; const int s = mtx / 3, kind = mtx % 3; const size_t wo = (size_t)(l * 2 + s) * DM * DFF;
        if (kind == 0) { w.W = p.in[I_WG] + wo; w.K = DM; w.N = DFF; w.WT = GP(bf16_t, s ? WS_W1B : WS_W1A); mode = 1; w.gk = p.in[I_NORMG] + (size_t)(l * 6 + (s ? 4 : 0)) * DM; }
        else if (kind == 1) { w.W = p.in[I_WU] + wo; w.K = DM; w.N = DFF; w.WT = GP(bf16_t, s ? WS_W1B : WS_W1A); mode = 2; w.gk = p.in[I_NORMG] + (size_t)(l * 6 + (s ? 4 : 0)) * DM; }
        else { w.W = p.in[I_WD] + wo; w.K = DFF; w.N = DM; w.WT = GP(bf16_t, s ? WS_W2B : WS_W2A); } }
    else { r = it - 6 * FI;
        if (r < n_in) { w.K = DM; w.WT = GP(bf16_t, WS_WIN); w.gk = p.in[I_NORMG] + (size_t)(l * 6 + 2) * DM; if (even) { w.W = p.in[I_EVIN] + (size_t)j * DM * EV_N; w.N = EV_N; } else { w.W = p.in[I_ODIN] + (size_t)j * DM * OD_N; w.N = OD_N; } }
        else if (r < n_in + n_out) { r -= n_in; w.K = DM; w.N = DM; w.WT = GP(bf16_t, WS_WOUT); w.W = (even ? p.in[I_EVOUT] : p.in[I_ODOUT]) + (size_t)j * DM * DM; }
        else { r -= n_in + n_out; w.big = false;
            if (even) { const int mi = r >> 2; r &= 3; w.K = 128; w.N = 128; const int hd = mi & 7; w.W = (mi < 8 ? p.in[I_LWA] : p.in[I_LWX]) + (size_t)(j * 8 + hd) * 16384; w.WT = GP(bf16_t, mi < 8 ? WS_WAT : WS_WXT) + hd * 16384; }
            else { const int g = r >> 4; r &= 15; w.K = 256; w.N = 256; w.W = p.in[I_POOLW] + (size_t)(j * 4 + g) * 65536; w.WT = GP(bf16_t, WS_POOLT) + g * 65536; } } }
    const int nkb = w.K >> 6, nbi = r / nkb, kb = r % nkb;
    w.n0 = nbi * 64; w.k0 = kb * 64; w.drow0 = mode == 0 ? w.n0 : ((w.n0 >> 7) * 256 + (w.n0 & 127) + (mode == 2 ? 128 : 0));
    return w;
}
__device__ __forceinline__ void tr_load(const WItem& w, f32x4 (&v)[16], float& gl, int lane) {
    const int r4 = lane >> 4, c16 = lane & 15, nl = w.n0 + 4 * c16; const bool ok = nl < w.N;
    gl = w.gk ? w.gk[w.k0 + lane] : 1.0f;
    const float* src = w.W + (size_t)(w.k0 + r4) * w.N + nl; const size_t step = (size_t)4 * w.N;
#pragma unroll
    for (int i = 0; i < 16; ++i) { v[i] = ok ? __builtin_nontemporal_load((const f32x4*)src) : F4ZERO; src += step; asm volatile("" : "+v"(src)); }
}
__device__ __forceinline__ void tr_store(const WItem& w, const f32x4 (&v)[16], float gl, LAS float* scr, int lane) {
    const int r4 = lane >> 4, c16 = lane & 15;
#pragma unroll
    for (int i = 0; i < 16; ++i) { const float gg = __shfl(gl, 4 * i + r4); LAS float* d = scr + (4 * i + r4) * 65 + 4 * c16; d[0] = v[i][0] * gg; d[1] = v[i][1] * gg; d[2] = v[i][2] * gg; d[3] = v[i][3] * gg; }
    asm volatile("s_waitcnt lgkmcnt(0)" ::: "memory");
    const int c = lane & 7;
#pragma unroll
    for (int jj = 0; jj < 8; ++jj) { const int nn = (lane >> 3) + 8 * jj; const LAS float* s = scr + (8 * c) * 65 + nn;
        u32x4 o; o.x = pk2(s[0 * 65], s[1 * 65]); o.y = pk2(s[2 * 65], s[3 * 65]); o.z = pk2(s[4 * 65], s[5 * 65]); o.w = pk2(s[6 * 65], s[7 * 65]);
        if (w.n0 + nn < w.N) { const int dr = w.drow0 + nn; bf16_t* dst = w.big ? w.WT + ((((size_t)(dr >> 8) * (w.K >> 6) + (w.k0 >> 6)) * 256 + (dr & 255)) << 6) + 8 * c : w.WT + (size_t)dr * w.K + w.k0 + 8 * c; asm volatile("global_store_dwordx4 %0, %1, off sc1\n\ts_nop 1" :: "v"(dst), "v"(o) : "memory"); } }
    asm volatile("s_waitcnt lgkmcnt(0)" ::: "memory");
}
__device__ __forceinline__ void ph_weights(const KP& p, int l, LAS unsigned char* lds) {
    const int tid = otid(), lane = tid & 63, wave = tid >> 6;
    LAS float* scr = (LAS float*)(lds + wave * 16640);
    const int gw = obid() * NWAVES + wave, NGW = gridDim.x * NWAVES;
    const bool even = (l & 1) == 0;
    constexpr int FI = (DM / 64) * (DFF / 64);
    const int n_in = even ? (DM / 64) * ((EV_N + 63) / 64) : (DM / 64) * (OD_N / 64), n_out = (DM / 64) * (DM / 64);
    const int total = 6 * FI + n_in + n_out + 64;
    f32x4 v[16]; float gl = 1.0f;
    if (gw < total) { const WItem w0 = w_item(p, l, gw); tr_load(w0, v, gl, lane); }
    for (int it = gw; it < total; it += NGW) {
        const int itn = it + NGW; f32x4 vn[16]; float gln = 1.0f;
        if (itn < total) { const WItem wn = w_item(p, l, itn); tr_load(wn, vn, gln, lane); }
        { const WItem wc = w_item(p, l, it); tr_store(wc, v, gl, scr, lane); }
        gl = gln;
#pragma unroll
        for (int i = 0; i < 16; ++i) v[i] = vn[i];
    }
    if (even) {
        bf16_t* pz = GP(bf16_t, WS_WIN) + (size_t)(EV_N >> 8) * DM * 256; constexpr int per_kt = (256 - (EV_N & 255)) * 64 * 2 / 16;
        for (int i = obid() * NTHREADS + tid; i < (DM / 64) * per_kt; i += gridDim.x * NTHREADS) { const int kt = i / per_kt, o = i % per_kt; ((u32x4*)(pz + ((size_t)kt * 256 + (EV_N & 255)) * 64))[o] = (u32x4){0u, 0u, 0u, 0u}; }
    }
}

constexpr int Q_FI = (DM / 64) * (DFF / 64), Q_NOUT = (DM / 64) * (DM / 64), CW_QCTR = 8192;
__device__ __forceinline__ int q_nin(int l) { return (l & 1) ? (DM / 64) * (OD_N / 64) : (DM / 64) * ((EV_N + 63) / 64); }
__device__ __forceinline__ int q_total(int l, int part) { return part == 0 ? 3 * Q_FI + q_nin(l) + 64 : 3 * Q_FI + Q_NOUT; }
__device__ __forceinline__ int q_map(int l, int part, int q) {
    const int nin = q_nin(l);
    if (part == 0) return q < 3 * Q_FI ? q : (q < 3 * Q_FI + nin ? 6 * Q_FI + (q - 3 * Q_FI) : 6 * Q_FI + nin + Q_NOUT + (q - 3 * Q_FI - nin));
    return q < 3 * Q_FI ? 3 * Q_FI + q : 6 * Q_FI + nin + (q - 3 * Q_FI);
}
__device__ __forceinline__ bool fill_step(const KP& p, int l, int part, LAS unsigned char* lds) {
    if (l < 0 || l >= DEPTH) return false;
    const int tid = otid(), lane = tid & 63, wave = __builtin_amdgcn_readfirstlane(tid >> 6);
    LAS float* scr = (LAS float*)(lds + wave * 16640);
    const int total = q_total(l, part), home = (obid() + wave) & 7;
    unsigned* ctr0 = (unsigned*)(p.ws + WS_CTL) + CW_QCTR + (size_t)((l * 2 + part) * 8) * 64;
    for (int k = 0; k < 8; ++k) { const int sh = (home + k) & 7, cnt = (total - sh + 7) >> 3; unsigned* ctr = ctr0 + sh * 64;
        if ((int)__builtin_amdgcn_readfirstlane(__hip_atomic_load(ctr, __ATOMIC_RELAXED, __HIP_MEMORY_SCOPE_AGENT)) >= cnt) continue;
        unsigned jq = 0u; if (lane == 0) jq = __hip_atomic_fetch_add(ctr, 1u, __ATOMIC_RELAXED, __HIP_MEMORY_SCOPE_AGENT);
        jq = (unsigned)__builtin_amdgcn_readfirstlane((int)jq);
        if ((int)jq >= cnt) continue;
        const WItem w = w_item(p, l, q_map(l, part, (int)jq * 8 + sh)); f32x4 v[16]; float gl; tr_load(w, v, gl, lane); tr_store(w, v, gl, scr, lane);
        return true; }
    return false;
}
__device__ __forceinline__ void ph_weights_drain(const KP& p, int l, int part, LAS unsigned char* lds) {
    while (fill_step(p, l, part, lds)) {}
    if (part == 0 && (l & 1) == 0) {
        const int tid = otid(); bf16_t* pz = GP(bf16_t, WS_WIN) + (size_t)(EV_N >> 8) * DM * 256; constexpr int per_kt = (256 - (EV_N & 255)) * 64 * 2 / 16;
        for (int i = obid() * NTHREADS + tid; i < (DM / 64) * per_kt; i += gridDim.x * NTHREADS) { const int kt = i / per_kt, o = i % per_kt; ((u32x4*)(pz + ((size_t)kt * 256 + (EV_N & 255)) * 64))[o] = (u32x4){0u, 0u, 0u, 0u}; }
    }
}
__device__ __forceinline__ void ph_weights_part(const KP& p, int l, int part, LAS unsigned char* lds) {
    const int tid = otid(), lane = tid & 63, wave = tid >> 6;
    LAS float* scr = (LAS float*)(lds + wave * 16640);
    const int gw = obid() * NWAVES + wave, NGW = gridDim.x * NWAVES, total = q_total(l, part);
    for (int q = gw; q < total; q += NGW) { const WItem w = w_item(p, l, q_map(l, part, q)); f32x4 v[16]; float gl; tr_load(w, v, gl, lane); tr_store(w, v, gl, scr, lane); }
    if (part == 0 && (l & 1) == 0) {
        bf16_t* pz = GP(bf16_t, WS_WIN) + (size_t)(EV_N >> 8) * DM * 256; constexpr int per_kt = (256 - (EV_N & 255)) * 64 * 2 / 16;
        for (int i = obid() * NTHREADS + tid; i < (DM / 64) * per_kt; i += gridDim.x * NTHREADS) { const int kt = i / per_kt, o = i % per_kt; ((u32x4*)(pz + ((size_t)kt * 256 + (EV_N & 255)) * 64))[o] = (u32x4){0u, 0u, 0u, 0u}; }
    }
}

#define XB_OFF(r, lane) ((((size_t)((r) >> 8) * 32 + ((lane) >> 3)) * 256 + ((r) & 255)) * 64 + 8 * ((lane) & 7))
#define XB_JSTEP (8 * 256 * 64 / 8)
__device__ __forceinline__ size_t mix_off(int r, int c) { return ((((size_t)(r >> 8) * 32 + (c >> 6)) * 256 + (r & 255)) << 6) + (c & 63); }
__device__ __forceinline__ void ph_norm0(const float* xin, bf16_t* xb, float* rsq) {
    const int tid = otid(), lane = tid & 63, wave = tid >> 6;
    const int gw = obid() * NWAVES + wave, NGW = gridDim.x * NWAVES;
    f32x4 vn[8];
    if (gw < M) { const f32x4* xr = (const f32x4*)(xin + (size_t)gw * DM) + 2 * lane;
#pragma unroll
        for (int jx = 0; jx < 4; ++jx) { vn[2 * jx] = __builtin_nontemporal_load(xr + 128 * jx); vn[2 * jx + 1] = __builtin_nontemporal_load(xr + 128 * jx + 1); } }
    for (int row = gw; row < M; row += NGW) {
        f32x4 v[8]; float ss = 0.f;
#pragma unroll
        for (int jx = 0; jx < 8; ++jx) v[jx] = vn[jx];
        const int nrow = row + NGW;
        if (nrow < M) { const f32x4* xr = (const f32x4*)(xin + (size_t)nrow * DM) + 2 * lane;
#pragma unroll
            for (int jx = 0; jx < 4; ++jx) { vn[2 * jx] = __builtin_nontemporal_load(xr + 128 * jx); vn[2 * jx + 1] = __builtin_nontemporal_load(xr + 128 * jx + 1); } }
#pragma unroll
        for (int jx = 0; jx < 8; ++jx) ss += (v[jx][0] * v[jx][0] + v[jx][1] * v[jx][1]) + (v[jx][2] * v[jx][2] + v[jx][3] * v[jx][3]);
        ss = wave_sum(ss); if (lane == 0) rsq[row] = rsqrtf(ss * (1.0f / DM) + EPS);
        u32x4* xo = (u32x4*)(xb + XB_OFF(row, lane));
#pragma unroll
        for (int jx = 0; jx < 4; ++jx) { const f32x4 a = v[2 * jx], c = v[2 * jx + 1]; xo[XB_JSTEP * jx] = (u32x4){pk2(a[0], a[1]), pk2(a[2], a[3]), pk2(c[0], c[1]), pk2(c[2], c[3])}; }
    }
}
__device__ __forceinline__ void ph_norm(const bf16_t* xin, const bf16_t* h, float scale, const float* ga, bf16_t* xout16, float* xout32, float* rsq) {
    const int tid = otid(), lane = tid & 63, wave = tid >> 6;
    const int gw = obid() * NWAVES + wave, NGW = gridDim.x * NWAVES;
    u32x4 xn[4], hn[4];
    if (gw < M) { const u32x4* xr = (const u32x4*)(xin + XB_OFF(gw, lane)); const u32x4* hr = (const u32x4*)(h + (size_t)gw * DM) + lane;
#pragma unroll
        for (int jx = 0; jx < 4; ++jx) { xn[jx] = xr[XB_JSTEP * jx]; hn[jx] = __builtin_nontemporal_load(hr + 64 * jx); } }
    f32x4 gq[8];
#pragma unroll
    for (int jx = 0; jx < 4; ++jx) { gq[2 * jx] = ((const f32x4*)ga)[128 * jx + 2 * lane]; gq[2 * jx + 1] = ((const f32x4*)ga)[128 * jx + 2 * lane + 1]; }
    for (int row = gw; row < M; row += NGW) {
        u32x4 xw[4], hw[4];
#pragma unroll
        for (int jx = 0; jx < 4; ++jx) { xw[jx] = xn[jx]; hw[jx] = hn[jx]; }
        const int nrow = row + NGW;
        if (nrow < M) { const u32x4* xr = (const u32x4*)(xin + XB_OFF(nrow, lane)); const u32x4* hr = (const u32x4*)(h + (size_t)nrow * DM) + lane;
#pragma unroll
            for (int jx = 0; jx < 4; ++jx) { xn[jx] = xr[XB_JSTEP * jx]; hn[jx] = __builtin_nontemporal_load(hr + 64 * jx); } }
        float hv[32]; float ss = 0.f;
#pragma unroll
        for (int jx = 0; jx < 4; ++jx) { const unsigned w4[4] = {hw[jx].x, hw[jx].y, hw[jx].z, hw[jx].w};
#pragma unroll
            for (int e = 0; e < 4; ++e) { const float a = bflo(w4[e]), c = bfhi(w4[e]); hv[8 * jx + 2 * e] = a; hv[8 * jx + 2 * e + 1] = c; ss += a * a + c * c; } }
        ss = wave_sum(ss); const float rsh = rsqrtf(ss * (1.0f / DM) + EPS) * scale;
        float xv[32]; float s2 = 0.f;
#pragma unroll
        for (int jx = 0; jx < 4; ++jx) { const unsigned w4[4] = {xw[jx].x, xw[jx].y, xw[jx].z, xw[jx].w}; const f32x4 g0 = gq[2 * jx], g1 = gq[2 * jx + 1];
            const float g8[8] = {g0[0], g0[1], g0[2], g0[3], g1[0], g1[1], g1[2], g1[3]};
#pragma unroll
            for (int e = 0; e < 4; ++e) { const float a = bflo(w4[e]) + hv[8 * jx + 2 * e] * g8[2 * e] * rsh, c = bfhi(w4[e]) + hv[8 * jx + 2 * e + 1] * g8[2 * e + 1] * rsh; xv[8 * jx + 2 * e] = a; xv[8 * jx + 2 * e + 1] = c; s2 += a * a + c * c; } }
        s2 = wave_sum(s2); if (lane == 0) rsq[row] = rsqrtf(s2 * (1.0f / DM) + EPS);
        if (xout16) { u32x4* xo = (u32x4*)(xout16 + XB_OFF(row, lane));
#pragma unroll
            for (int jx = 0; jx < 4; ++jx) xo[XB_JSTEP * jx] = (u32x4){pk2(xv[8 * jx], xv[8 * jx + 1]), pk2(xv[8 * jx + 2], xv[8 * jx + 3]), pk2(xv[8 * jx + 4], xv[8 * jx + 5]), pk2(xv[8 * jx + 6], xv[8 * jx + 7])}; }
        if (xout32) { f32x4* xo = (f32x4*)(xout32 + (size_t)row * DM) + 2 * lane;
#pragma unroll
            for (int jx = 0; jx < 4; ++jx) { xo[128 * jx] = (f32x4){xv[8 * jx], xv[8 * jx + 1], xv[8 * jx + 2], xv[8 * jx + 3]}; xo[128 * jx + 1] = (f32x4){xv[8 * jx + 4], xv[8 * jx + 5], xv[8 * jx + 6], xv[8 * jx + 7]}; } }
    }
}

struct LruC { bf16x8 fa[4], fx[4]; float w0, w1, w2, w3, cb, ba, bx, sp; };
struct LruPre { u32x4 rv[3]; };
__device__ __forceinline__ void lru_local_consts(const KP& p, LruC& C, int j, int hd, int tid) {
    const int lane = tid & 63, wave = tid >> 6, c0 = hd * 128, ccq = c0 + (tid & 127), cj = c0 + wave * 16 + (lane & 15);
    const bf16_t* waT = GP(const bf16_t, WS_WAT) + (size_t)hd * 16384; const bf16_t* wxT = GP(const bf16_t, WS_WXT) + (size_t)hd * 16384;
#pragma unroll
    for (int ks = 0; ks < 4; ++ks) { C.fa[ks] = glb_frag(waT, 128, wave * 16, ks * 32, lane); C.fx[ks] = glb_frag(wxT, 128, wave * 16, ks * 32, lane); }
    const float* cw = p.in[I_LCW] + (size_t)j * 4096; C.w0 = cw[ccq]; C.w1 = cw[1024 + ccq]; C.w2 = cw[2048 + ccq]; C.w3 = cw[3072 + ccq]; C.cb = p.in[I_LCB][j * 1024 + ccq];
    C.ba = p.in[I_LBA][j * 1024 + cj]; C.bx = p.in[I_LBX][j * 1024 + cj]; C.sp = softplus_neg_f(p.in[I_LLAM][j * 1024 + cj]);
#pragma unroll
    for (int ks = 0; ks < 4; ++ks) { asm volatile("" : "+v"(C.fa[ks])); asm volatile("" : "+v"(C.fx[ks])); }
    asm volatile("" : "+v"(C.w0), "+v"(C.w1), "+v"(C.w2), "+v"(C.w3), "+v"(C.cb), "+v"(C.ba), "+v"(C.bx), "+v"(C.sp));
}
__device__ __forceinline__ void lru_local_load(const KP& p, LruPre& P, int b, int n, int hd, int tid) {
    const bf16_t* Z = GP(const bf16_t, WS_HB); const int row0 = b * SEQ + n * 64, c0 = hd * 128;
#pragma unroll
    for (int k = 0; k < 3; ++k) { const int idx = tid + NTHREADS * k, rr = idx >> 4, sg = idx & 15; P.rv[k] = (u32x4){0u, 0u, 0u, 0u};
        if (idx < 67 * 16 && n * 64 + rr - 3 >= 0) P.rv[k] = *(const u32x4*)(Z + (size_t)(row0 + rr - 3) * EV_NP + c0 + sg * 8); }
}
__device__ __forceinline__ void lru_local_unit(const KP& p, const LruC& C, int b, int n, int hd, LAS unsigned char* lds, LruPre& pre, bool has_next, int b2, int n2, int hd2) {
    const int tid = otid(), lane = tid & 63, wave = __builtin_amdgcn_readfirstlane(tid >> 6);
    LAS bf16_t* A = (LAS bf16_t*)lds;
    LAS bf16_t* Rw = (LAS bf16_t*)(lds + 17408);
    LAS float* LA = (LAS float*)(lds + 35840); LAS float* BI = (LAS float*)(lds + 69632); LAS float* SEG = (LAS float*)(lds + 103424);
    const int row0 = b * SEQ + n * 64, c0 = hd * 128;
    const int cq = tid & 127, q = tid >> 7, ccq = c0 + cq;
    const float w0 = C.w0, w1 = C.w1, w2 = C.w2, w3 = C.w3, cb = C.cb;
    const int jj = wave * 16 + (lane & 15);
    const float ba = C.ba, bx = C.bx;
#pragma unroll
    for (int k = 0; k < 3; ++k) { const int idx = tid + NTHREADS * k, rr = idx >> 4, sg = idx & 15; if (idx < 67 * 16) *(LAS u32x4*)(Rw + rr * 136 + sg * 8) = pre.rv[k]; }
    if (has_next) lru_local_load(p, pre, b2, n2, hd2, tid);
    __syncthreads();
    { const int t0 = q * 16; float x3 = bf2f(Rw[t0 * 136 + cq]), x2 = bf2f(Rw[(t0 + 1) * 136 + cq]), x1 = bf2f(Rw[(t0 + 2) * 136 + cq]);
#pragma unroll
      for (int i = 0; i < 16; ++i) { const int t = t0 + i; const float xv = bf2f(Rw[(t + 3) * 136 + cq]); A[t * 136 + cq] = f2bf(w0 * x3 + w1 * x2 + w2 * x1 + w3 * xv + cb); x3 = x2; x2 = x1; x1 = xv; } }
    __syncthreads();
    { f32x4 aa[4], ax[4];
#pragma unroll
      for (int tt = 0; tt < 4; ++tt) { aa[tt] = F4ZERO; ax[tt] = F4ZERO; }
#pragma unroll
      for (int ks = 0; ks < 4; ++ks)
#pragma unroll
          for (int tt = 0; tt < 4; ++tt) { const bf16x8 af = lds_frag(A, 136, tt * 16, ks * 32, lane); aa[tt] = MFMA16(af, C.fa[ks], aa[tt]); ax[tt] = MFMA16(af, C.fx[ks], ax[tt]); }
      const float sp = C.sp;
#pragma unroll
      for (int tt = 0; tt < 4; ++tt)
#pragma unroll
          for (int i = 0; i < 4; ++i) { const int t = tt * 16 + (lane >> 4) * 4 + i; const float r = sigmoid_f(aa[tt][i] + ba), ig = sigmoid_f(ax[tt][i] + bx);
              const float la = -8.0f * r * sp, xcv = bf2f(A[t * 136 + jj]); LA[t * 132 + jj] = la; BI[t * 132 + jj] = __builtin_amdgcn_sqrtf(one_minus_exp_f(2.0f * la)) * ig * xcv; } }
    __syncthreads();
    { const int t0 = q * 16; float cs = 0.f, h = 0.f; float hs[16], cc_[16];
#pragma unroll
      for (int i = 0; i < 16; ++i) { const float la = LA[(t0 + i) * 132 + cq]; cs += la; h = __expf(la) * h + BI[(t0 + i) * 132 + cq]; hs[i] = h; cc_[i] = cs; }
      SEG[(q * 128 + cq) * 2] = cs; SEG[(q * 128 + cq) * 2 + 1] = h;
      __syncthreads();
      float Hs = 0.f, Cs = 0.f;
      for (int q2 = 0; q2 < q; ++q2) { const float a = SEG[(q2 * 128 + cq) * 2], hh = SEG[(q2 * 128 + cq) * 2 + 1]; Hs = __expf(a) * Hs + hh; Cs += a; }
#pragma unroll
      for (int i = 0; i < 16; ++i) { const int t = t0 + i; A[t * 136 + cq] = f2bf(hs[i] + __expf(cc_[i]) * Hs); Rw[t * 136 + cq] = f2bf(__expf(cc_[i] + Cs)); }
      if (q == 3) { const size_t ci = (size_t)(b * NCH + n) * 1024 + ccq; GP(float, WS_CARA)[ci] = __expf(cc_[15] + Cs); GP(float, WS_CARH)[ci] = hs[15] + __expf(cc_[15]) * Hs; } }
    __syncthreads();
    { const int t = tid >> 3, sg = tid & 7; const LAS u32x4* sh = (const LAS u32x4*)(A + t * 136 + sg * 16); const LAS u32x4* sa = (const LAS u32x4*)(Rw + t * 136 + sg * 16);
      u32x4* dh = (u32x4*)(GP(bf16_t, WS_HLOC) + (size_t)(row0 + t) * 1024 + c0 + sg * 16); u32x4* da = (u32x4*)(GP(bf16_t, WS_APROD) + (size_t)(row0 + t) * 1024 + c0 + sg * 16);
      dh[0] = sh[0]; dh[1] = sh[1]; da[0] = sa[0]; da[1] = sa[1]; }
    __syncthreads();
}

struct GlaUC { float gu[16], gb; };
struct GlaUPre { u32x4 k[2], v[4], g; };
__device__ __forceinline__ void gla_u_consts(const KP& p, GlaUC& C, int j, int h, int tid) {
#pragma unroll
    for (int r = 0; r < 16; ++r) C.gu[r] = p.in[I_GWG][(size_t)(j * 16 + r) * 512 + h * 128 + (tid & 127)];
    C.gb = p.in[I_GBG][j * 512 + h * 128 + (tid & 127)];
#pragma unroll
    for (int r = 0; r < 16; ++r) asm volatile("" : "+v"(C.gu[r]));
    asm volatile("" : "+v"(C.gb));
}
__device__ __forceinline__ void gla_u_load(const KP& p, GlaUPre& P, int b, int n, int h, int tid) {
    const bf16_t* Z = GP(const bf16_t, WS_HB); const int row0 = b * SEQ + n * 64;
    const int t = tid >> 3, sg = tid & 7; const bf16_t* zr = Z + (size_t)(row0 + t) * EV_NP;
    const u32x4* sk = (const u32x4*)(zr + 2560 + h * 128 + sg * 16); const u32x4* sv = (const u32x4*)(zr + 3072 + h * 256 + sg * 32);
    P.k[0] = sk[0]; P.k[1] = sk[1]; P.v[0] = sv[0]; P.v[1] = sv[1]; P.v[2] = sv[2]; P.v[3] = sv[3];
    if (tid < 128) { const int t2 = tid >> 1, half = tid & 1; P.g = *(const u32x4*)(Z + (size_t)(row0 + t2) * EV_NP + 5120 + half * 8); }
}
__device__ __forceinline__ void gla_u_unit(const KP& p, const GlaUC& C, int b, int n, int h, LAS unsigned char* lds, GlaUPre& pre, bool has_next, int b2, int n2, int h2, f32x4 (&ua)[16], const bool first) {
    const int tid = otid(), lane = tid & 63, wave = __builtin_amdgcn_readfirstlane(tid >> 6), g4 = lane >> 4;
    LAS bf16_t* Kr = (LAS bf16_t*)lds; LAS bf16_t* Vs = (LAS bf16_t*)(lds + 17408); LAS float* SEG = (LAS float*)(lds + 51200); LAS float* GLR = (LAS float*)(lds + 53248); LAS float* DEs = (LAS float*)(lds + 57344);
    const int ug = (b * NCH + n) * 4 + h;
    { const int t = tid >> 3, sg = tid & 7;
      LAS u32x4* dk = (LAS u32x4*)(Kr + t * 136 + sg * 16); dk[0] = pre.k[0]; dk[1] = pre.k[1];
      LAS u32x4* dv = (LAS u32x4*)(Vs + t * 264 + sg * 32); dv[0] = pre.v[0]; dv[1] = pre.v[1]; dv[2] = pre.v[2]; dv[3] = pre.v[3];
      if (tid < 128) { const int t2 = tid >> 1, half = tid & 1; const u32x4 w = pre.g; LAS float* gd = GLR + t2 * 16 + half * 8;
          gd[0] = bflo(w.x); gd[1] = bfhi(w.x); gd[2] = bflo(w.y); gd[3] = bfhi(w.y); gd[4] = bflo(w.z); gd[5] = bfhi(w.z); gd[6] = bflo(w.w); gd[7] = bfhi(w.w); } }
    if (has_next) gla_u_load(p, pre, b2, n2, h2, tid);
    const float gb = C.gb;
    __syncthreads();
    { const int d = tid & 127, q = tid >> 7;
      float lc[16]; float cs = 0.f;
#pragma unroll
      for (int i = 0; i < 16; ++i) { const int t = q * 16 + i; float pa = gb;
#pragma unroll
          for (int r = 0; r < 16; ++r) pa += GLR[t * 16 + r] * C.gu[r];
          cs += logsigmoid_f(pa) * 0.0625f; lc[i] = cs; }
      SEG[q * 128 + d] = cs;
      __syncthreads();
      float pref = 0.f, blast = 0.f;
#pragma unroll
      for (int q2 = 0; q2 < 4; ++q2) { const float s = SEG[q2 * 128 + d]; if (q2 < q) pref += s; blast += s; }
      float* bcg = GP(float, WS_BC) + (size_t)ug * 8192;
#pragma unroll
      for (int i = 0; i < 16; ++i) { const int t = q * 16 + i; const float bc = pref + lc[i]; const float kv = bf2f(Kr[t * 136 + d]); Kr[t * 136 + d] = f2bf(kv * __expf(blast - bc)); bcg[t * 128 + d] = bc; }
      if (q == 0) { const float de = __expf(blast); GP(float, WS_DEC)[(size_t)ug * 128 + d] = de; DEs[d] = de; } }
    __syncthreads();
    { bf16x8 a[2];
#pragma unroll
      for (int ks = 0; ks < 2; ++ks) a[ks] = tr_frag(Kr, 136, 32 * ks + 8 * g4, 32 * ks + 8 * g4 + 4, 16 * wave, lane);
      u32x2* ug_ = (u32x2*)GP(bf16_t, WS_UG) + (size_t)ug * 8192 + (size_t)(wave * 16) * 64 + lane;
      const f32x4 dq = *(const LAS f32x4*)(DEs + 16 * wave + 4 * g4);
#pragma unroll
      for (int jt = 0; jt < 16; ++jt) { const bf16x8 b0 = tr_frag(Vs, 264, 8 * g4, 8 * g4 + 4, 16 * jt, lane), b1 = tr_frag(Vs, 264, 32 + 8 * g4, 36 + 8 * g4, 16 * jt, lane);
          f32x4 acc = first ? F4ZERO : ua[jt] * dq; acc = MFMA16(a[0], b0, acc); acc = MFMA16(a[1], b1, acc); ua[jt] = acc;
          if (!first) { u32x2 w; w.x = pk2(acc[0], acc[1]); w.y = pk2(acc[2], acc[3]); ug_[jt * 64] = w; } } }
    __syncthreads();
}

__device__ __forceinline__ void ph_gla_state(const KP& p, LAS unsigned char* lds) {
    const int tid = otid(); const int G = gridDim.x; LAS float* DP = (LAS float*)lds;
    const u32x2* UG = (const u32x2*)GP(const bf16_t, WS_UG); const float* DEC = GP(const float, WS_DEC); u32x2* SS = (u32x2*)GP(bf16_t, WS_SS);
    for (int g0 = obid() * NTHREADS; g0 < BATCH * 4 * 8192; g0 += G * NTHREADS) {
        const int gi = g0 + tid, bh = g0 >> 13, e = gi & 8191, b = bh >> 2, h = bh & 3, dt = (g0 & 8191) >> 10, g4 = (tid & 63) >> 4;
        const size_t ug0 = (size_t)(b * NCH * 4 + h);
        auto load = [&](u32x2 (&U)[8], int pr0) {
#pragma unroll
            for (int k = 0; k < 8; ++k) U[k] = __builtin_nontemporal_load(UG + (ug0 + (size_t)(2 * (pr0 + k) + 1) * 4) * 8192 + e); };
        u32x2 Ua[8], Ub[8];
        load(Ua, 0);
        for (int i = tid; i < 1024; i += NTHREADS) { const int pr = i >> 4, dd = i & 15; const size_t ug = ug0 + (size_t)(2 * pr) * 4; DP[i] = DEC[ug * 128 + 16 * dt + dd] * DEC[(ug + 4) * 128 + 16 * dt + dd]; }
        __syncthreads();
        f32x4 S = F4ZERO;
        auto step = [&](const u32x2 (&U)[8], int pr0) {
#pragma unroll
            for (int k = 0; k < 8; ++k) { const int pr = pr0 + k; const size_t ug = ug0 + (size_t)(2 * pr) * 4; u32x2 w; w.x = pk2(S[0], S[1]); w.y = pk2(S[2], S[3]); __builtin_nontemporal_store(w, SS + ug * 8192 + e);
                S = S * *(const LAS f32x4*)(DP + pr * 16 + 4 * g4) + (f32x4){bflo(U[k].x), bfhi(U[k].x), bflo(U[k].y), bfhi(U[k].y)}; } };
        for (int pr0 = 0; pr0 < NCH / 2; pr0 += 16) {
            load(Ub, pr0 + 8); step(Ua, pr0);
            if (pr0 + 16 < NCH / 2) load(Ua, pr0 + 16);
            step(Ub, pr0 + 8); }
        __syncthreads();
    }
}

struct TilesGLA { u32x4 q[2], k[2], v[4]; f32x4 c[4]; float dec; };
__device__ __forceinline__ void gla_out_load(const KP& p, TilesGLA& T, int b, int n, int h, int tid) {
    const int t_ = tid >> 3, sg = tid & 7, row0 = b * SEQ + n * 64, ug = (b * NCH + n) * 4 + h; const bf16_t* zr = GP(const bf16_t, WS_HB) + (size_t)(row0 + t_) * EV_NP;
    const u32x4* sq = (const u32x4*)(zr + 2048 + h * 128 + sg * 16); const u32x4* sk = (const u32x4*)(zr + 2560 + h * 128 + sg * 16); const u32x4* sv = (const u32x4*)(zr + 3072 + h * 256 + sg * 32);
    const f32x4* sb = (const f32x4*)(GP(const float, WS_BC) + (size_t)ug * 8192 + t_ * 128 + sg * 16);
    T.q[0] = sq[0]; T.q[1] = sq[1]; T.k[0] = sk[0]; T.k[1] = sk[1];
#pragma unroll
    for (int c = 0; c < 4; ++c) { T.v[c] = sv[c]; T.c[c] = sb[c]; }
    if (tid < 128) T.dec = GP(const float, WS_DEC)[(size_t)ug * 128 + tid];
}
__device__ __forceinline__ void gla_out_unit(const KP& p, int j, int b, int n, int h, LAS unsigned char* lds, TilesGLA& pre, bool has_next, int b2, int n2, int h2, u32x2 (&sf)[2][8], const bool first) {
    const int tid = otid(), lane = tid & 63, wave = __builtin_amdgcn_readfirstlane(tid >> 6), g4 = lane >> 4;
    LAS bf16_t* Qd = (LAS bf16_t*)lds; LAS bf16_t* Ki = (LAS bf16_t*)(lds + 17408); LAS bf16_t* Vs = (LAS bf16_t*)(lds + 34816); LAS bf16_t* Ps = (LAS bf16_t*)(lds + 68608); LAS float* RSs = (LAS float*)(lds + 77824); LAS float* DEs = (LAS float*)(lds + 79872); LAS float* OST = (LAS float*)lds;
    const bf16_t* Z = GP(const bf16_t, WS_HB);
    const int row0 = b * SEQ + n * 64, ug = (b * NCH + n) * 4 + h;
    const int t_ = tid >> 3, sg = tid & 7; const bf16_t* zr = Z + (size_t)(row0 + t_) * EV_NP;
    u32x4 rr[4];
    { const u32x4 q0 = pre.q[0], q1 = pre.q[1], k0 = pre.k[0], k1 = pre.k[1], v0 = pre.v[0], v1 = pre.v[1], v2 = pre.v[2], v3 = pre.v[3]; const f32x4 c0 = pre.c[0], c1 = pre.c[1], c2 = pre.c[2], c3 = pre.c[3];
      if (first) { const u32x2* SS = (const u32x2*)GP(const bf16_t, WS_SS) + (size_t)ug * 8192 + lane;
#pragma unroll
        for (int j2 = 0; j2 < 2; ++j2)
#pragma unroll
            for (int dt = 0; dt < 8; ++dt) sf[j2][dt] = SS[(dt * 16 + 2 * wave + j2) * 64]; }
      LAS u32x4* dv = (LAS u32x4*)(Vs + t_ * 264 + sg * 32); dv[0] = v0; dv[1] = v1; dv[2] = v2; dv[3] = v3;
      const unsigned qw[8] = {q0.x, q0.y, q0.z, q0.w, q1.x, q1.y, q1.z, q1.w}, kw[8] = {k0.x, k0.y, k0.z, k0.w, k1.x, k1.y, k1.z, k1.w};
      const float bc[16] = {c0[0], c0[1], c0[2], c0[3], c1[0], c1[1], c1[2], c1[3], c2[0], c2[1], c2[2], c2[3], c3[0], c3[1], c3[2], c3[3]};
      unsigned qo[8], ko[8];
#pragma unroll
      for (int e = 0; e < 8; ++e) { const float e0 = __expf(bc[2 * e]), e1 = __expf(bc[2 * e + 1]);
          qo[e] = pk2(bflo(qw[e]) * 0.08838834764831845f * e0, bfhi(qw[e]) * 0.08838834764831845f * e1); ko[e] = pk2(bflo(kw[e]) * __builtin_amdgcn_rcpf(e0), bfhi(kw[e]) * __builtin_amdgcn_rcpf(e1)); }
      LAS u32x4* dq = (LAS u32x4*)(Qd + t_ * 136 + sg * 16); dq[0] = (u32x4){qo[0], qo[1], qo[2], qo[3]}; dq[1] = (u32x4){qo[4], qo[5], qo[6], qo[7]};
      LAS u32x4* dk = (LAS u32x4*)(Ki + t_ * 136 + sg * 16); dk[0] = (u32x4){ko[0], ko[1], ko[2], ko[3]}; dk[1] = (u32x4){ko[4], ko[5], ko[6], ko[7]}; }
    if (tid < 128) DEs[tid] = pre.dec;
    if (has_next) gla_out_load(p, pre, b2, n2, h2, tid);
    __syncthreads();
    { const int tt = wave >> 1, stb = (wave & 1) * 2; f32x4 acc[2] = {F4ZERO, F4ZERO};
      if (stb <= tt) {
#pragma unroll
          for (int ks = 0; ks < 4; ++ks) { const bf16x8 a = lds_frag(Qd, 136, tt * 16, ks * 32, lane);
#pragma unroll
              for (int s2 = 0; s2 < 2; ++s2) acc[s2] = MFMA16(a, lds_frag(Ki, 136, (stb + s2) * 16, ks * 32, lane), acc[s2]); } }
#pragma unroll
      for (int s2 = 0; s2 < 2; ++s2)
#pragma unroll
          for (int i = 0; i < 4; ++i) { const int t = tt * 16 + g4 * 4 + i, s = (stb + s2) * 16 + (lane & 15); Ps[t * 72 + s] = (s <= t) ? f2bf(acc[s2][i]) : (bf16_t)0; } }
    __syncthreads();
    f32x4 o[2][4];
#pragma unroll
    for (int j2 = 0; j2 < 2; ++j2)
#pragma unroll
        for (int tt = 0; tt < 4; ++tt) o[j2][tt] = F4ZERO;
#pragma unroll
    for (int k2 = 0; k2 < 2; ++k2) { bf16x8 bfr[4];
#pragma unroll
        for (int tt = 0; tt < 4; ++tt) bfr[tt] = lds_frag(Ps, 72, 16 * tt, 32 * k2, lane);
#pragma unroll
        for (int j2 = 0; j2 < 2; ++j2) { const bf16x8 a = tr_frag(Vs, 264, 32 * k2 + 8 * g4, 32 * k2 + 8 * g4 + 4, 16 * (2 * wave + j2), lane);
#pragma unroll
            for (int tt = 0; tt < 4; ++tt) o[j2][tt] = MFMA16(a, bfr[tt], o[j2][tt]); } }
#pragma unroll
    for (int ks = 0; ks < 4; ++ks) { bf16x8 bfr[4];
#pragma unroll
        for (int tt = 0; tt < 4; ++tt) bfr[tt] = lds_frag_perm(Qd, 136, 16 * tt, 32 * ks, lane);
#pragma unroll
        for (int j2 = 0; j2 < 2; ++j2) { const u32x4 w = {sf[j2][2 * ks].x, sf[j2][2 * ks].y, sf[j2][2 * ks + 1].x, sf[j2][2 * ks + 1].y}; const bf16x8 a = __builtin_bit_cast(bf16x8, w);
#pragma unroll
            for (int tt = 0; tt < 4; ++tt) o[j2][tt] = MFMA16(a, bfr[tt], o[j2][tt]); } }
    if (first) {
        const LAS float* decp = DEs + 4 * g4;
#pragma unroll
        for (int j2 = 0; j2 < 2; ++j2) { const bf16x8 bv0 = tr_frag(Vs, 264, 8 * g4, 8 * g4 + 4, 16 * (2 * wave + j2), lane), bv1 = tr_frag(Vs, 264, 32 + 8 * g4, 36 + 8 * g4, 16 * (2 * wave + j2), lane);
#pragma unroll
            for (int dq = 0; dq < 8; dq += 2) { f32x4 sa[2];
#pragma unroll
                for (int d2 = 0; d2 < 2; ++d2) { const int dt = dq + d2; sa[d2] = (f32x4){bflo(sf[j2][dt].x), bfhi(sf[j2][dt].x), bflo(sf[j2][dt].y), bfhi(sf[j2][dt].y)};
                    sa[d2] = MFMA16(tr_frag(Ki, 136, 8 * g4, 8 * g4 + 4, 16 * dt, lane), bv0, sa[d2]); sa[d2] = MFMA16(tr_frag(Ki, 136, 32 + 8 * g4, 36 + 8 * g4, 16 * dt, lane), bv1, sa[d2]); }
#pragma unroll
                for (int d2 = 0; d2 < 2; ++d2) { const int dt = dq + d2; const f32x4 dc = *(const LAS f32x4*)(decp + 16 * dt); const f32x4 r = sa[d2] * dc; sf[j2][dt].x = pk2(r[0], r[1]); sf[j2][dt].y = pk2(r[2], r[3]); } } } }
#pragma unroll
    for (int tt = 0; tt < 4; ++tt) { float ss = 0.f;
#pragma unroll
        for (int j2 = 0; j2 < 2; ++j2) ss += (o[j2][tt][0] * o[j2][tt][0] + o[j2][tt][1] * o[j2][tt][1]) + (o[j2][tt][2] * o[j2][tt][2] + o[j2][tt][3] * o[j2][tt][3]);
        ss += __shfl_xor(ss, 16); ss += __shfl_xor(ss, 32);
        if (lane < 16) RSs[wave * 64 + 16 * tt + lane] = ss; }
    { const u32x4* sr = (const u32x4*)(zr + 4096 + h * 256 + sg * 32); rr[0] = sr[0]; rr[1] = sr[1]; rr[2] = sr[2]; rr[3] = sr[3]; }
    f32x4 gnv[8];
    { const f32x4* gn = (const f32x4*)(p.in[I_GNORM] + j * 1024 + h * 256 + sg * 32);
#pragma unroll
      for (int c = 0; c < 8; ++c) gnv[c] = gn[c]; }
    __syncthreads();
#pragma unroll
    for (int tt = 0; tt < 4; ++tt) { const int t = 16 * tt + (lane & 15); float tot = 0.f;
#pragma unroll
        for (int w2 = 0; w2 < 8; ++w2) tot += RSs[w2 * 64 + t];
        const float rs = rsqrtf(tot * (1.0f / 256.0f) + EPS);
#pragma unroll
        for (int j2 = 0; j2 < 2; ++j2) *(LAS f32x4*)(OST + t * 260 + 16 * (2 * wave + j2) + 4 * g4) = o[j2][tt] * rs; }
    __syncthreads();
    { u32x4* dst = (u32x4*)(GP(bf16_t, WS_U) + mix_off(row0 + t_, 1024 + h * 256 + sg * 32));
#pragma unroll
      for (int c = 0; c < 4; ++c) { const u32x4 rw = rr[c]; const f32x4 oa = *(const LAS f32x4*)(OST + t_ * 260 + sg * 32 + 8 * c), ob = *(const LAS f32x4*)(OST + t_ * 260 + sg * 32 + 8 * c + 4), ga = gnv[2 * c], gb = gnv[2 * c + 1];
          u32x4 w; w.x = pk2(oa[0] * ga[0] * pg8::silu_f(bflo(rw.x)), oa[1] * ga[1] * pg8::silu_f(bfhi(rw.x))); w.y = pk2(oa[2] * ga[2] * pg8::silu_f(bflo(rw.y)), oa[3] * ga[3] * pg8::silu_f(bfhi(rw.y)));
          w.z = pk2(ob[0] * gb[0] * pg8::silu_f(bflo(rw.z)), ob[1] * gb[1] * pg8::silu_f(bfhi(rw.z))); w.w = pk2(ob[2] * gb[2] * pg8::silu_f(bflo(rw.w)), ob[3] * gb[3] * pg8::silu_f(bfhi(rw.w)));
          dst[c] = w; } }
    __syncthreads();
}

__device__ __forceinline__ void lru_fix_unit(const KP& p, int b, int np, LAS unsigned char* lds) {
    const int tid = otid(); const int c8 = tid & 127, c = 8 * c8, rq = tid >> 7;
    LAS float* CQ = (LAS float*)lds;
    const float* CA = GP(const float, WS_CARA) + (size_t)b * NCH * 1024 + c; const float* CH = GP(const float, WS_CARH) + (size_t)b * NCH * 1024 + c;
    float H[8];
    { const int nprev = 2 * np, per = (nprev + 3) >> 2, lo = rq * per, hi = (lo + per < nprev) ? lo + per : nprev;
      float Aq[8], Hq[8];
#pragma unroll
      for (int e = 0; e < 8; ++e) { Aq[e] = 1.f; Hq[e] = 0.f; }
      for (int n0 = lo; n0 < hi; n0 += 8) {
          f32x4 a[8][2], hh[8][2];
#pragma unroll
          for (int k = 0; k < 8; ++k) { const bool ok = n0 + k < hi; const size_t o = (size_t)(ok ? n0 + k : 0) * 1024;
              a[k][0] = *(const f32x4*)(CA + o); a[k][1] = *(const f32x4*)(CA + o + 4); hh[k][0] = *(const f32x4*)(CH + o); hh[k][1] = *(const f32x4*)(CH + o + 4);
              if (!ok) { a[k][0] = (f32x4){1.f, 1.f, 1.f, 1.f}; a[k][1] = a[k][0]; hh[k][0] = F4ZERO; hh[k][1] = F4ZERO; } }
#pragma unroll
          for (int k = 0; k < 8; ++k)
#pragma unroll
              for (int e = 0; e < 8; ++e) { Hq[e] = a[k][e >> 2][e & 3] * Hq[e] + hh[k][e >> 2][e & 3]; Aq[e] *= a[k][e >> 2][e & 3]; }
      }
      LAS f32x4* dq = (LAS f32x4*)(CQ + (rq * 128 + c8) * 16);
      dq[0] = (f32x4){Aq[0], Aq[1], Aq[2], Aq[3]}; dq[1] = (f32x4){Aq[4], Aq[5], Aq[6], Aq[7]}; dq[2] = (f32x4){Hq[0], Hq[1], Hq[2], Hq[3]}; dq[3] = (f32x4){Hq[4], Hq[5], Hq[6], Hq[7]};
      __syncthreads();
#pragma unroll
      for (int e = 0; e < 8; ++e) H[e] = 0.f;
#pragma unroll
      for (int q2 = 0; q2 < 4; ++q2) { const LAS f32x4* sq = (const LAS f32x4*)(CQ + (q2 * 128 + c8) * 16); const f32x4 a0 = sq[0], a1 = sq[1], h0 = sq[2], h1 = sq[3];
#pragma unroll
          for (int e = 0; e < 4; ++e) { H[e] = a0[e] * H[e] + h0[e]; H[4 + e] = a1[e] * H[4 + e] + h1[e]; } }
      __syncthreads(); }
    for (int half = 0; half < 2; ++half) { const int n = 2 * np + half, row0 = b * SEQ + n * 64 + rq * 16;
        const bf16_t* hl = GP(const bf16_t, WS_HLOC) + (size_t)row0 * 1024 + c; const bf16_t* ap = GP(const bf16_t, WS_APROD) + (size_t)row0 * 1024 + c;
        const bf16_t* yb = GP(const bf16_t, WS_HB) + (size_t)row0 * EV_NP + 1024 + c; bf16_t* mix = GP(bf16_t, WS_U);
        const f32x4 an0 = *(const f32x4*)(CA + (size_t)n * 1024), an1 = *(const f32x4*)(CA + (size_t)n * 1024 + 4), hn0 = *(const f32x4*)(CH + (size_t)n * 1024), hn1 = *(const f32x4*)(CH + (size_t)n * 1024 + 4);
        for (int t0 = 0; t0 < 16; t0 += 8) {
            u32x4 wh[8], wa[8], wy[8];
#pragma unroll
            for (int k = 0; k < 8; ++k) { wh[k] = *(const u32x4*)(hl + (size_t)(t0 + k) * 1024); wa[k] = *(const u32x4*)(ap + (size_t)(t0 + k) * 1024); wy[k] = *(const u32x4*)(yb + (size_t)(t0 + k) * EV_NP); }
#pragma unroll
            for (int k = 0; k < 8; ++k) { const unsigned h4[4] = {wh[k].x, wh[k].y, wh[k].z, wh[k].w}, a4[4] = {wa[k].x, wa[k].y, wa[k].z, wa[k].w}, y4[4] = {wy[k].x, wy[k].y, wy[k].z, wy[k].w}; unsigned o4[4];
#pragma unroll
                for (int e = 0; e < 4; ++e) { const float h0 = bflo(h4[e]) + bflo(a4[e]) * H[2 * e], h1 = bfhi(h4[e]) + bfhi(a4[e]) * H[2 * e + 1]; o4[e] = pk2(h0 * gelu_tanh_f(bflo(y4[e])), h1 * gelu_tanh_f(bfhi(y4[e]))); }
                *(u32x4*)(mix + mix_off(row0 + t0 + k, c)) = (u32x4){o4[0], o4[1], o4[2], o4[3]}; }
        }
#pragma unroll
        for (int e = 0; e < 4; ++e) { H[e] = an0[e] * H[e] + hn0[e]; H[4 + e] = an1[e] * H[4 + e] + hn1[e]; }
    }
}

__device__ __forceinline__ void mlstm_tok_unit(const KP& p, int j, int b, int n, LAS unsigned char* lds) {
    const int tid = otid(), lane = tid & 63, wave = tid >> 6;
    LAS float* RED = (LAS float*)lds;
    const bf16_t* Z = GP(const bf16_t, WS_HB);
    const int g = tid & 255, th = tid >> 8, c = 4 * g, row0 = b * SEQ + n * 64, t0 = th * 32, pos0 = n * 64 + t0;
    LAS float* TB = (LAS float*)(lds + 8192) + g * 68;
    float cw[4][4], cb[4], wq[4][4], wk[4][4], wv[4][4];
#pragma unroll
    for (int k = 0; k < 4; ++k)
#pragma unroll
        for (int i = 0; i < 4; ++i) cw[k][i] = p.in[I_MCW][(size_t)(j * 4 + k) * 1024 + c + i];
#pragma unroll
    for (int i = 0; i < 4; ++i) cb[i] = p.in[I_MCB][j * 1024 + c + i];
#pragma unroll
    for (int i = 0; i < 4; ++i)
#pragma unroll
        for (int jj = 0; jj < 4; ++jj) { const size_t wi = ((size_t)(j * 256 + g) * 4 + i) * 4 + jj; wq[i][jj] = p.in[I_MWQ][wi]; wk[i][jj] = p.in[I_MWK][wi]; wv[i][jj] = p.in[I_MWV][wi]; }
    { const float* wif = p.in[I_MWIF] + (size_t)j * 3072 * 8;
#pragma unroll
      for (int i = 0; i < 4; ++i)
#pragma unroll
          for (int G = 0; G < 8; ++G) { float a = 0.f, v = 0.f;
#pragma unroll
              for (int jj = 0; jj < 4; ++jj) { a += wq[i][jj] * wif[(size_t)(c + jj) * 8 + G] + wk[i][jj] * wif[(size_t)(1024 + c + jj) * 8 + G]; v += wv[i][jj] * wif[(size_t)(2048 + c + jj) * 8 + G]; }
              TB[i * 8 + G] = a; TB[32 + i * 8 + G] = v; } }
    const bf16_t* zp = Z + (size_t)row0 * OD_N + c;
    float x3[4] = {0.f, 0.f, 0.f, 0.f}, x2[4] = {0.f, 0.f, 0.f, 0.f}, x1[4] = {0.f, 0.f, 0.f, 0.f};
    if (pos0 >= 3) { const u32x2 w = *(const u32x2*)(zp + (ptrdiff_t)(t0 - 3) * OD_N); x3[0] = bflo(w.x); x3[1] = bfhi(w.x); x3[2] = bflo(w.y); x3[3] = bfhi(w.y); }
    if (pos0 >= 2) { const u32x2 w = *(const u32x2*)(zp + (ptrdiff_t)(t0 - 2) * OD_N); x2[0] = bflo(w.x); x2[1] = bfhi(w.x); x2[2] = bflo(w.y); x2[3] = bfhi(w.y); }
    if (pos0 >= 1) { const u32x2 w = *(const u32x2*)(zp + (ptrdiff_t)(t0 - 1) * OD_N); x1[0] = bflo(w.x); x1[1] = bfhi(w.x); x1[2] = bflo(w.y); x1[3] = bfhi(w.y); }
    bf16_t* XC = GP(bf16_t, WS_XC) + (size_t)row0 * 1024 + c; bf16_t* Qb = GP(bf16_t, WS_Q) + (size_t)row0 * 1024 + c; bf16_t* Kb = GP(bf16_t, WS_KB) + (size_t)row0 * 1024 + c; bf16_t* Vb = GP(bf16_t, WS_V) + (size_t)row0 * 1024 + c;
    for (int i0 = 0; i0 < 32; i0 += 8) {
        u32x2 xw[8];
#pragma unroll
        for (int k8 = 0; k8 < 8; ++k8) xw[k8] = *(const u32x2*)(zp + (size_t)(t0 + i0 + k8) * OD_N);
#pragma unroll
        for (int k8 = 0; k8 < 8; ++k8) { const int t = t0 + i0 + k8; const u32x2 w = xw[k8];
        float xm[4] = {bflo(w.x), bfhi(w.x), bflo(w.y), bfhi(w.y)}; float xc[4], q[4], k[4], v[4];
#pragma unroll
        for (int ch = 0; ch < 4; ++ch) { const float a = cw[0][ch] * x3[ch] + cw[1][ch] * x2[ch] + cw[2][ch] * x1[ch] + cw[3][ch] * xm[ch] + cb[ch]; xc[ch] = pg8::silu_f(a); x3[ch] = x2[ch]; x2[ch] = x1[ch]; x1[ch] = xm[ch]; }
#pragma unroll
        for (int jj = 0; jj < 4; ++jj) { q[jj] = xc[0] * wq[0][jj] + xc[1] * wq[1][jj] + xc[2] * wq[2][jj] + xc[3] * wq[3][jj]; k[jj] = xc[0] * wk[0][jj] + xc[1] * wk[1][jj] + xc[2] * wk[2][jj] + xc[3] * wk[3][jj];
            v[jj] = xm[0] * wv[0][jj] + xm[1] * wv[1][jj] + xm[2] * wv[2][jj] + xm[3] * wv[3][jj]; }
        { u32x2 o; o.x = pk2(xc[0], xc[1]); o.y = pk2(xc[2], xc[3]); *(u32x2*)(XC + (size_t)t * 1024) = o; }
        { u32x2 o; o.x = pk2(q[0], q[1]); o.y = pk2(q[2], q[3]); *(u32x2*)(Qb + (size_t)t * 1024) = o; }
        { u32x2 o; o.x = pk2(k[0] * 0.0625f, k[1] * 0.0625f); o.y = pk2(k[2] * 0.0625f, k[3] * 0.0625f); *(u32x2*)(Kb + (size_t)t * 1024) = o; }
        { u32x2 o; o.x = pk2(v[0], v[1]); o.y = pk2(v[2], v[3]); *(u32x2*)(Vb + (size_t)t * 1024) = o; }
        float gp[8];
#pragma unroll
        for (int G = 0; G < 8; ++G) gp[G] = 0.f;
#pragma unroll
        for (int i = 0; i < 4; ++i) { const f32x4 q0 = *(const LAS f32x4*)(TB + i * 8), q1 = *(const LAS f32x4*)(TB + i * 8 + 4), v0 = *(const LAS f32x4*)(TB + 32 + i * 8), v1 = *(const LAS f32x4*)(TB + 32 + i * 8 + 4);
#pragma unroll
            for (int G = 0; G < 4; ++G) { gp[G] += xc[i] * q0[G] + xm[i] * v0[G]; gp[4 + G] += xc[i] * q1[G] + xm[i] * v1[G]; } }
        float r4[4], r2[2], r1;
        { const bool hi = (lane & 32) != 0;
#pragma unroll
          for (int q4 = 0; q4 < 4; ++q4) { const float keep = hi ? gp[4 + q4] : gp[q4], send = hi ? gp[q4] : gp[4 + q4]; r4[q4] = keep + __shfl_xor(send, 32); } }
        { const bool hi = (lane & 16) != 0;
#pragma unroll
          for (int q2 = 0; q2 < 2; ++q2) { const float keep = hi ? r4[2 + q2] : r4[q2], send = hi ? r4[q2] : r4[2 + q2]; r2[q2] = keep + __shfl_xor(send, 16); } }
        { const bool hi = (lane & 8) != 0; const float keep = hi ? r2[1] : r2[0], send = hi ? r2[0] : r2[1]; r1 = keep + __shfl_xor(send, 8); }
        r1 += __shfl_xor(r1, 4); r1 += __shfl_xor(r1, 2); r1 += __shfl_xor(r1, 1);
        if ((lane & 7) == 0) RED[(t * 4 + (wave & 3)) * 8 + ((lane >> 3) & 7)] = r1;
        }
    }
    __syncthreads();
    { const int t = tid >> 3, G = tid & 7; const float s = p.in[I_MBIF][j * 8 + G] + (RED[(t * 4 + 0) * 8 + G] + RED[(t * 4 + 1) * 8 + G]) + (RED[(t * 4 + 2) * 8 + G] + RED[(t * 4 + 3) * 8 + G]);
      GP(float, WS_GATES)[(size_t)(row0 + t) * 8 + G] = s; }
    __syncthreads();
}

struct PoolPre { u32x4 rv[5]; };
__device__ __forceinline__ void pool_load(const KP& p, PoolPre& P, int b, int n, int g, int tid) {
    const bf16_t* Z = GP(const bf16_t, WS_HB); const int row0 = b * SEQ + n * 64;
#pragma unroll
    for (int k = 0; k < 5; ++k) { const int idx = tid + NTHREADS * k, rr = idx >> 5, sg = idx & 31; P.rv[k] = (u32x4){0u, 0u, 0u, 0u};
        if (idx < 79 * 32 && n * 64 + rr - 15 >= 0) P.rv[k] = *(const u32x4*)(Z + (size_t)(row0 + rr - 15) * OD_N + 2048 + g * 256 + sg * 8); }
}
__device__ __forceinline__ void pool_unit(const KP& p, int j, int b, int n, int g, LAS unsigned char* lds, PoolPre& pre) {
    const int tid = otid(), lane = tid & 63, wave = __builtin_amdgcn_readfirstlane(tid >> 6);
    LAS bf16_t* R = (LAS bf16_t*)lds;
    LAS bf16_t* A = (LAS bf16_t*)(lds + 41728);
    const int row0 = b * SEQ + n * 64;
    bf16x8 pf[2][8];
    { const bf16_t* PT = GP(const bf16_t, WS_POOLT) + (size_t)g * 65536;
#pragma unroll
      for (int jt = 0; jt < 2; ++jt)
#pragma unroll
          for (int ks = 0; ks < 8; ++ks) pf[jt][ks] = glb_frag(PT, 256, (2 * wave + jt) * 16, ks * 32, lane); }
#pragma unroll
    for (int k = 0; k < 5; ++k) { const int idx = tid + NTHREADS * k, rr = idx >> 5, sg = idx & 31; if (idx < 79 * 32) *(LAS u32x4*)(R + rr * 264 + sg * 8) = pre.rv[k]; }
    if (g < 3) pool_load(p, pre, b, n, g + 1, tid);
    __syncthreads();
    { const int c = tid & 255, th = tid >> 8, win = 2 << g, t0 = th * 32, pos0 = n * 64 + t0;
      float S = 0.f;
      for (int k = 1; k < win; ++k) S += bf2f(R[(15 + t0 - k) * 264 + c]);
#pragma unroll 8
      for (int i = 0; i < 32; ++i) { const int t = t0 + i, pos = pos0 + i; const float xv = bf2f(R[(15 + t) * 264 + c]); S += xv;
          const float cnt = (float)((pos + 1 < win) ? pos + 1 : win); A[t * 264 + c] = f2bf(S * __builtin_amdgcn_rcpf(cnt) - xv);
          S -= bf2f(R[(15 + t - win + 1) * 264 + c]); } }
    __syncthreads();
    { f32x4 acc[2][4];
#pragma unroll
      for (int jt = 0; jt < 2; ++jt)
#pragma unroll
          for (int tt = 0; tt < 4; ++tt) acc[jt][tt] = F4ZERO;
#pragma unroll
      for (int ks = 0; ks < 8; ++ks) {
          bf16x8 bfr[4];
#pragma unroll
          for (int tt = 0; tt < 4; ++tt) bfr[tt] = lds_frag(A, 264, tt * 16, ks * 32, lane);
#pragma unroll
          for (int jt = 0; jt < 2; ++jt)
#pragma unroll
              for (int tt = 0; tt < 4; ++tt) acc[jt][tt] = MFMA16(pf[jt][ks], bfr[tt], acc[jt][tt]); }
      bf16_t* MIX = GP(bf16_t, WS_U);
#pragma unroll
      for (int jt = 0; jt < 2; ++jt) { const int jj = (2 * wave + jt) * 16 + (lane >> 4) * 4; const f32x4 sc = *(const f32x4*)(p.in[I_POOLS] + j * 1024 + g * 256 + jj);
#pragma unroll
          for (int tt = 0; tt < 4; ++tt) { const int t = tt * 16 + (lane & 15); const f32x4 o = acc[jt][tt] * sc; u32x2 w; w.x = pk2(o[0], o[1]); w.y = pk2(o[2], o[3]);
              *(u32x2*)(MIX + mix_off(row0 + t, 1024 + g * 256 + jj)) = w; } } }
    __syncthreads();
}

struct MuPre { u32x4 k[4], v[4]; float iv, gf; };
__device__ __forceinline__ void mlstm_u_load(const KP& p, MuPre& P, int b, int n, int h, int tid) {
    const int row0 = b * SEQ + n * 64, t = tid >> 3, sg = tid & 7;
    const u32x4* sk = (const u32x4*)(GP(const bf16_t, WS_KB) + (size_t)(row0 + t) * 1024 + h * 256 + sg * 32); const u32x4* sv = (const u32x4*)(GP(const bf16_t, WS_V) + (size_t)(row0 + t) * 1024 + h * 256 + sg * 32);
#pragma unroll
    for (int c = 0; c < 4; ++c) { P.k[c] = sk[c]; P.v[c] = sv[c]; }
    if (tid < 64) { const float* gt = GP(const float, WS_GATES) + (size_t)(row0 + tid) * 8; P.iv = gt[h]; P.gf = gt[4 + h]; }
}
__device__ __forceinline__ void mlstm_u_unit(const KP& p, int b, int n, int h, LAS unsigned char* lds, MuPre& pre, PoolPre& ppre) {
    const int tid = otid(), lane = tid & 63, wave = __builtin_amdgcn_readfirstlane(tid >> 6), g4 = lane >> 4;
    LAS bf16_t* Ks = (LAS bf16_t*)lds; LAS bf16_t* Vw = (LAS bf16_t*)(lds + 33792); LAS float* wl = (LAS float*)(lds + 67584);
    const int row0 = b * SEQ + n * 64, ug = (b * NCH + n) * 4 + h; (void)row0;
    if (wave == 0) { const int t = lane; const float iv = pre.iv, lf = logsigmoid_f(pre.gf);
        float bcum = lf;
#pragma unroll
        for (int o = 1; o < 64; o <<= 1) { const float v = __shfl_up(bcum, o); if (lane >= o) bcum += v; }
        const float bL = __shfl(bcum, 63), gg = bL - bcum + iv, mg = wave_max(gg);
        wl[t] = __expf(gg - mg);
        if (lane == 0) { GP(float, WS_SC)[ug * 2] = bL; GP(float, WS_SC)[ug * 2 + 1] = mg; } }
    const int t = tid >> 3, sg = tid & 7;
    u32x4 vv[4];
    { LAS u32x4* dk = (LAS u32x4*)(Ks + t * 264 + sg * 32); dk[0] = pre.k[0]; dk[1] = pre.k[1]; dk[2] = pre.k[2]; dk[3] = pre.k[3]; vv[0] = pre.v[0]; vv[1] = pre.v[1]; vv[2] = pre.v[2]; vv[3] = pre.v[3]; }
    if (h < 3) mlstm_u_load(p, pre, b, n, h + 1, tid); else pool_load(p, ppre, b, n, 0, tid);
    __syncthreads();
    { const float w = wl[t]; LAS u32x4* dv = (LAS u32x4*)(Vw + t * 264 + sg * 32);
#pragma unroll
      for (int c = 0; c < 4; ++c) { u32x4 o; o.x = pk2(bflo(vv[c].x) * w, bfhi(vv[c].x) * w); o.y = pk2(bflo(vv[c].y) * w, bfhi(vv[c].y) * w); o.z = pk2(bflo(vv[c].z) * w, bfhi(vv[c].z) * w); o.w = pk2(bflo(vv[c].w) * w, bfhi(vv[c].w) * w); dv[c] = o; } }
    __syncthreads();
    { bf16x8 a[2][2];
#pragma unroll
      for (int d2 = 0; d2 < 2; ++d2)
#pragma unroll
          for (int ks = 0; ks < 2; ++ks) a[d2][ks] = tr_frag(Ks, 264, 32 * ks + 8 * g4, 32 * ks + 8 * g4 + 4, 16 * (2 * wave + d2), lane);
      u32x2* um = (u32x2*)GP(bf16_t, WS_UM) + (size_t)ug * 16384 + lane;
#pragma unroll 4
      for (int jt = 0; jt < 16; ++jt) { const bf16x8 b0 = tr_frag(Vw, 264, 8 * g4, 8 * g4 + 4, 16 * jt, lane), b1 = tr_frag(Vw, 264, 32 + 8 * g4, 36 + 8 * g4, 16 * jt, lane);
#pragma unroll
          for (int d2 = 0; d2 < 2; ++d2) { f32x4 acc = MFMA16(a[d2][0], b0, F4ZERO); acc = MFMA16(a[d2][1], b1, acc); u32x2 w; w.x = pk2(acc[0], acc[1]); w.y = pk2(acc[2], acc[3]); um[((2 * wave + d2) * 16 + jt) * 64] = w; } } }
    if (tid < 256) { float s = 0.f;
#pragma unroll 8
        for (int s2 = 0; s2 < 64; ++s2) s += wl[s2] * bf2f(Ks[s2 * 264 + tid]);
        GP(float, WS_NU)[(size_t)ug * 256 + tid] = s; }
    __syncthreads();
}

__device__ __forceinline__ void ph_mlstm_state(const KP& p) {
    const int tid = otid(); const int G = gridDim.x, blk = obid();
    const u32x2* UM = (const u32x2*)GP(const bf16_t, WS_UM); u32x2* CS = (u32x2*)GP(bf16_t, WS_CS); const float* SC = GP(const float, WS_SC);
    const float* NU = GP(const float, WS_NU); float* NS = GP(float, WS_NS); float* MS = GP(float, WS_MS);
    int ci = tid < 4 ? blk * 4 + tid : (1 << 30);
    for (int gi = blk * NTHREADS + tid; gi < BATCH * 4 * 16384; gi += G * NTHREADS) {
        const int bh = gi >> 14, e = gi & 16383; const size_t ug0 = (size_t)((bh >> 2) * NCH * 4 + (bh & 3));
        const bool have = ci < BATCH * 4 * 64; const int bh2 = have ? ci >> 6 : 0, d4 = ci & 63; const size_t vg0 = (size_t)((bh2 >> 2) * NCH * 4 + (bh2 & 3));
        f32x4 C = F4ZERO, nv = F4ZERO; float m = 0.f, m2 = 0.f;
        for (int n0 = 0; n0 < NCH; n0 += 16) {
            u32x2 uw[16]; float2 sc2[16];
#pragma unroll
            for (int k = 0; k < 16; ++k) { const size_t ug = ug0 + (size_t)(n0 + k) * 4; uw[k] = __builtin_nontemporal_load(UM + ug * 16384 + e); sc2[k] = *(const float2*)(SC + ug * 2); }
            if (have) {
                f32x4 nu[16]; float2 sd2[16];
#pragma unroll
                for (int k = 0; k < 16; ++k) { const size_t vg = vg0 + (size_t)(n0 + k) * 4; nu[k] = *(const f32x4*)(NU + vg * 256 + 4 * d4); sd2[k] = *(const float2*)(SC + vg * 2); }
#pragma unroll
                for (int k = 0; k < 16; ++k) { const size_t vg = vg0 + (size_t)(n0 + k) * 4; const float bL = sd2[k].x, mg = sd2[k].y;
                    *(f32x4*)(NS + vg * 256 + 4 * d4) = nv; if (d4 == 0) MS[vg] = m2;
                    const float m_new = fmaxf(bL + m2, mg), decay = __expf(bL + m2 - m_new), sc = __expf(mg - m_new);
                    nv = nv * decay + nu[k] * sc; m2 = m_new; } }
#pragma unroll
            for (int k = 0; k < 16; ++k) { const size_t ug = ug0 + (size_t)(n0 + k) * 4; const float bL = sc2[k].x, mg = sc2[k].y;
                u32x2 w; w.x = pk2(C[0], C[1]); w.y = pk2(C[2], C[3]); __builtin_nontemporal_store(w, CS + ug * 16384 + e);
                const float m_new = fmaxf(bL + m, mg), decay = __expf(bL + m - m_new), sc = __expf(mg - m_new);
                C = C * decay + (f32x4){bflo(uw[k].x), bfhi(uw[k].x), bflo(uw[k].y), bfhi(uw[k].y)} * sc; m = m_new; }
        }
        if (have) ci += 4 * G;
    }
    for (; ci < BATCH * 4 * 64; ci += 4 * G) {
        const int bh2 = ci >> 6, d4 = ci & 63; const size_t vg0 = (size_t)((bh2 >> 2) * NCH * 4 + (bh2 & 3)); f32x4 nv = F4ZERO; float m2 = 0.f;
        for (int n = 0; n < NCH; ++n) { const size_t vg = vg0 + (size_t)n * 4; const f32x4 nu = *(const f32x4*)(NU + vg * 256 + 4 * d4); const float bL = SC[vg * 2], mg = SC[vg * 2 + 1];
            *(f32x4*)(NS + vg * 256 + 4 * d4) = nv; if (d4 == 0) MS[vg] = m2;
            const float m_new = fmaxf(bL + m2, mg), decay = __expf(bL + m2 - m_new), sc = __expf(mg - m_new); nv = nv * decay + nu * sc; m2 = m_new; }
    }
}

struct TilesML { u32x4 q[4], k[4], v[4]; float iv, gf, nv, m; };
__device__ __forceinline__ void mlstm_out_load(const KP& p, TilesML& T, int b, int n, int h, int tid) {
    const size_t ro = (size_t)(b * SEQ + n * 64 + (tid >> 3)) * 1024 + h * 256 + (tid & 7) * 32;
    const u32x4* sq = (const u32x4*)(GP(const bf16_t, WS_Q) + ro); const u32x4* sk = (const u32x4*)(GP(const bf16_t, WS_KB) + ro); const u32x4* sv = (const u32x4*)(GP(const bf16_t, WS_V) + ro);
#pragma unroll
    for (int c = 0; c < 4; ++c) { T.q[c] = sq[c]; T.k[c] = sk[c]; T.v[c] = sv[c]; }
    const int ug = (b * NCH + n) * 4 + h;
    if (tid < 64) { const float* gt = GP(const float, WS_GATES) + (size_t)(b * SEQ + n * 64 + tid) * 8; T.iv = gt[h]; T.gf = gt[4 + h]; }
    if (tid < 256) T.nv = GP(const float, WS_NS)[(size_t)ug * 256 + tid];
    T.m = GP(const float, WS_MS)[ug];
}
__device__ __forceinline__ void mlstm_out_unit(const KP& p, int j, int b, int n, int h, LAS unsigned char* lds, TilesML& pre, bool has_next, int b2, int n2, int h2) {
    const int tid = otid(), lane = tid & 63, wave = __builtin_amdgcn_readfirstlane(tid >> 6), g4 = lane >> 4;
    LAS bf16_t* Qs = (LAS bf16_t*)lds; LAS bf16_t* Ks = (LAS bf16_t*)(lds + 33792); LAS bf16_t* Vs = (LAS bf16_t*)(lds + 67584);
    LAS float* bc = (LAS float*)(lds + 101376); LAS float* ig = bc + 64; LAS float* ml = bc + 128; LAS float* qnp = (LAS float*)(lds + 102144); LAS float* RSs = (LAS float*)(lds + 104192); LAS float* nvec = (LAS float*)(lds + 106240);
    LAS bf16_t* Ps = (LAS bf16_t*)(lds + 107264); LAS float* denp = (LAS float*)(lds + 116480); LAS float* OST = (LAS float*)lds;
    const int row0 = b * SEQ + n * 64, ug = (b * NCH + n) * 4 + h;
    const int t_ = tid >> 3, sg = tid & 7, c0 = h * 256 + sg * 32;
    u32x2 cf[2][16];
    { const u32x2* CS = (const u32x2*)GP(const bf16_t, WS_CS) + (size_t)ug * 16384 + lane;
#pragma unroll
      for (int j2 = 0; j2 < 2; ++j2)
#pragma unroll
          for (int dt = 0; dt < 16; ++dt) cf[j2][dt] = CS[(dt * 16 + 2 * wave + j2) * 64]; }
    if (wave == 0) { const int t = lane; const float iv = pre.iv, lf = logsigmoid_f(pre.gf);
        float bcum = lf;
#pragma unroll
        for (int o = 1; o < 64; o <<= 1) { const float v = __shfl_up(bcum, o); if (lane >= o) bcum += v; }
        float pm = iv - bcum;
#pragma unroll
        for (int o = 1; o < 64; o <<= 1) { const float v = __shfl_up(pm, o); if (lane >= o) pm = fmaxf(pm, v); }
        bc[t] = bcum; ig[t] = iv; ml[t] = bcum + pm; }
    { LAS u32x4* dq = (LAS u32x4*)(Qs + t_ * 264 + sg * 32); LAS u32x4* dk = (LAS u32x4*)(Ks + t_ * 264 + sg * 32); LAS u32x4* dv = (LAS u32x4*)(Vs + t_ * 264 + sg * 32);
#pragma unroll
      for (int c = 0; c < 4; ++c) { dq[c] = pre.q[c]; dk[c] = pre.k[c]; dv[c] = pre.v[c]; }
      if (tid < 256) nvec[tid] = pre.nv; }
    const float m = pre.m;
    __syncthreads();
    { const int t = tid & 63, part = tid >> 6; float s = 0.f;
#pragma unroll
      for (int dd = 0; dd < 32; dd += 2) { const unsigned w = *(const LAS unsigned*)(Qs + t * 264 + part * 32 + dd); s += bflo(w) * nvec[part * 32 + dd] + bfhi(w) * nvec[part * 32 + dd + 1]; }
      qnp[part * 64 + t] = s; }
    { const int tt = wave >> 1, stb = (wave & 1) * 2; f32x4 acc[2] = {F4ZERO, F4ZERO};
      if (stb <= tt) {
#pragma unroll
          for (int ks = 0; ks < 8; ++ks) { const bf16x8 a = lds_frag(Qs, 264, tt * 16, ks * 32, lane);
#pragma unroll
              for (int s2 = 0; s2 < 2; ++s2) acc[s2] = MFMA16(a, lds_frag(Ks, 264, (stb + s2) * 16, ks * 32, lane), acc[s2]); } }
#pragma unroll
      for (int s2 = 0; s2 < 2; ++s2) { const int s = (stb + s2) * 16 + (lane & 15); const float es = ig[s] - bc[s];
#pragma unroll
          for (int i = 0; i < 4; ++i) { const int t = tt * 16 + g4 * 4 + i; float pv = (s <= t) ? acc[s2][i] * __expf(bc[t] + es - ml[t]) : 0.f; Ps[t * 72 + s] = f2bf(pv);
              pv += __shfl_xor(pv, 1); pv += __shfl_xor(pv, 2); pv += __shfl_xor(pv, 4); pv += __shfl_xor(pv, 8);
              if ((lane & 15) == 0) denp[t * 4 + stb + s2] = pv; } } }
    u32x4 xr[4], zq[4];
    { const u32x4* sx = (const u32x4*)(GP(const bf16_t, WS_XC) + (size_t)(row0 + t_) * 1024 + c0); const u32x4* sz = (const u32x4*)(GP(const bf16_t, WS_HB) + (size_t)(row0 + t_) * OD_N + 1024 + c0);
#pragma unroll
      for (int c = 0; c < 4; ++c) { xr[c] = sx[c]; zq[c] = sz[c]; } }
    if (has_next) mlstm_out_load(p, pre, b2, n2, h2, tid);
    __syncthreads();
    f32x4 aN[2][4], aI[2][4];
#pragma unroll
    for (int j2 = 0; j2 < 2; ++j2)
#pragma unroll
        for (int tt = 0; tt < 4; ++tt) { aN[j2][tt] = F4ZERO; aI[j2][tt] = F4ZERO; }
#pragma unroll
    for (int k2 = 0; k2 < 2; ++k2) { bf16x8 bfr[4];
#pragma unroll
        for (int tt = 0; tt < 4; ++tt) bfr[tt] = lds_frag(Ps, 72, 16 * tt, 32 * k2, lane);
#pragma unroll
        for (int j2 = 0; j2 < 2; ++j2) { const bf16x8 a = tr_frag(Vs, 264, 32 * k2 + 8 * g4, 32 * k2 + 8 * g4 + 4, 16 * (2 * wave + j2), lane);
#pragma unroll
            for (int tt = 0; tt < 4; ++tt) aN[j2][tt] = MFMA16(a, bfr[tt], aN[j2][tt]); } }
#pragma unroll
    for (int ks = 0; ks < 8; ++ks) { bf16x8 bfr[4];
#pragma unroll
        for (int tt = 0; tt < 4; ++tt) bfr[tt] = lds_frag_perm(Qs, 264, 16 * tt, 32 * ks, lane);
#pragma unroll
        for (int j2 = 0; j2 < 2; ++j2) { const u32x4 w = {cf[j2][2 * ks].x, cf[j2][2 * ks].y, cf[j2][2 * ks + 1].x, cf[j2][2 * ks + 1].y}; const bf16x8 a = __builtin_bit_cast(bf16x8, w);
#pragma unroll
            for (int tt = 0; tt < 4; ++tt) aI[j2][tt] = MFMA16(a, bfr[tt], aI[j2][tt]); } }
#pragma unroll
    for (int tt = 0; tt < 4; ++tt) { const int t = 16 * tt + (lane & 15); float qn = 0.f;
#pragma unroll
        for (int pp = 0; pp < 8; ++pp) qn += qnp[pp * 64 + t];
        const float denl = (denp[t * 4] + denp[t * 4 + 1]) + (denp[t * 4 + 2] + denp[t * 4 + 3]);
        const float mt = fmaxf(bc[t] + m, ml[t]), el = __expf(ml[t] - mt), ei = __expf(bc[t] + m - mt), den = el * denl + ei * qn, inv = __builtin_amdgcn_rcpf(fmaxf(fabsf(den), __expf(-mt)));
        float ss = 0.f;
#pragma unroll
        for (int j2 = 0; j2 < 2; ++j2) { const f32x4 o = (aN[j2][tt] * el + aI[j2][tt] * ei) * inv; aN[j2][tt] = o; ss += (o[0] * o[0] + o[1] * o[1]) + (o[2] * o[2] + o[3] * o[3]); }
        ss += __shfl_xor(ss, 16); ss += __shfl_xor(ss, 32);
        if (lane < 16) RSs[wave * 64 + 16 * tt + lane] = ss; }
    f32x4 mnv[8], skv[8];
    { const f32x4* mn = (const f32x4*)(p.in[I_MNORM] + j * 1024 + c0); const f32x4* sk = (const f32x4*)(p.in[I_MSKIP] + j * 1024 + c0);
#pragma unroll
      for (int c = 0; c < 8; ++c) { mnv[c] = mn[c]; skv[c] = sk[c]; } }
    __syncthreads();
#pragma unroll
    for (int tt = 0; tt < 4; ++tt) { const int t = 16 * tt + (lane & 15); float tot = 0.f;
#pragma unroll
        for (int w2 = 0; w2 < 8; ++w2) tot += RSs[w2 * 64 + t];
        const float rs = rsqrtf(tot * (1.0f / 256.0f) + EPS);
#pragma unroll
        for (int j2 = 0; j2 < 2; ++j2) *(LAS f32x4*)(OST + t * 260 + 16 * (2 * wave + j2) + 4 * g4) = aN[j2][tt] * rs; }
    __syncthreads();
    { u32x4* dst = (u32x4*)(GP(bf16_t, WS_U) + mix_off(row0 + t_, c0));
#pragma unroll
      for (int c = 0; c < 4; ++c) { const u32x4 xw = xr[c], zw = zq[c]; const f32x4 oa = *(const LAS f32x4*)(OST + t_ * 260 + sg * 32 + 8 * c), ob = *(const LAS f32x4*)(OST + t_ * 260 + sg * 32 + 8 * c + 4), ma = mnv[2 * c], mb = mnv[2 * c + 1], sa = skv[2 * c], sb = skv[2 * c + 1];
          u32x4 w; w.x = pk2(sigmoid_f(bflo(zw.x)) * (oa[0] * ma[0] + sa[0] * bflo(xw.x)), sigmoid_f(bfhi(zw.x)) * (oa[1] * ma[1] + sa[1] * bfhi(xw.x)));
          w.y = pk2(sigmoid_f(bflo(zw.y)) * (oa[2] * ma[2] + sa[2] * bflo(xw.y)), sigmoid_f(bfhi(zw.y)) * (oa[3] * ma[3] + sa[3] * bfhi(xw.y)));
          w.z = pk2(sigmoid_f(bflo(zw.z)) * (ob[0] * mb[0] + sb[0] * bflo(xw.z)), sigmoid_f(bfhi(zw.z)) * (ob[1] * mb[1] + sb[1] * bfhi(xw.z)));
          w.w = pk2(sigmoid_f(bflo(zw.w)) * (ob[2] * mb[2] + sb[2] * bflo(xw.w)), sigmoid_f(bfhi(zw.w)) * (ob[3] * mb[3] + sb[3] * bfhi(xw.w)));
          dst[c] = w; } }
    __syncthreads();
}

#ifndef PROBE
#define PROBE 0
#endif
enum Phase { PH_INIT = 0, PH_FFN1, PH_FFN2, PH_FNORM, PH_MIN, PH_E2, PH_E3, PH_E4, PH_O2, PH_O3, PH_O4, PH_O5, PH_MOUT, PH_MNORM };

template <int PH> __device__ __forceinline__ void run_phase(const KP& p, int l, int s, LAS unsigned char* lds, const bool DRY = false) {
    const int j = l >> 1, G = gridDim.x, blk = obid();
    const float* ng = p.in[I_NORMG] + (size_t)l * 6 * DM;
    if constexpr (PH == PH_INIT) {
        if (!(PROBE == 18 && DRY)) ph_norm0(p.in[I_X], GP(bf16_t, WS_XB), GP(float, WS_RS));
        if (!(PROBE == 19 && DRY)) ph_weights_part(p, 0, 0, lds);
    } else if constexpr (PH == PH_FFN1) {
        const int hf = s >> 1, ss = s & 1; constexpr int MH = M / FFN_SPLIT;
        pg8::Gemm g{GP(const bf16_t, WS_XB) + (size_t)hf * MH * DM, GP(const bf16_t, ss ? WS_W1B : WS_W1A), MH, 2 * DFF, DM}; pg8::StaticOrder S; S.init(MH, 2 * DFF, G, blk, WGM_FFN1);
        pg8::EpiSwiglu E{GP(bf16_t, WS_HB) + (size_t)hf * MH * DFF, DFF, GP(const float, WS_RS) + (size_t)hf * MH};
        pg8::gemm_phase<pg8::EpiSwiglu, pg8::StaticOrder, true, true, true, true>(lds, g, S, E);
    } else if constexpr (PH == PH_FFN2) {
        const int hf = s >> 1, ss = s & 1; constexpr int MH = M / FFN_SPLIT;
        pg8::Gemm g{GP(const bf16_t, WS_HB) + (size_t)hf * MH * DFF, GP(const bf16_t, ss ? WS_W2B : WS_W2A), MH, DM, DFF}; pg8::StaticOrder S; S.init(MH, DM, G, blk, WGM_FFN2);
        pg8::EpiBf16P E{GP(bf16_t, WS_HO) + (size_t)hf * MH * DM, DM, nullptr};
        pg8::gemm_phase<pg8::EpiBf16P, pg8::StaticOrder, true, true, true, true>(lds, g, S, E);
    } else if constexpr (PH == PH_FNORM) {
        const float* ga = ng + (s ? 5 : 1) * DM; const bool last = (s == 1 && l == DEPTH - 1);
        ph_norm(GP(const bf16_t, WS_XB), GP(const bf16_t, WS_HO), 0.5f, ga, (last || DRY) ? nullptr : GP(bf16_t, WS_XB), (last && !DRY) ? p.out : nullptr, GP(float, WS_RS));
        if (s == 1 && l + 1 < DEPTH) ph_weights_drain(p, l + 1, 0, lds);
    } else if constexpr (PH == PH_MIN) {
        const int N = (l & 1) ? OD_N : EV_NP;
        pg8::Gemm g{GP(const bf16_t, WS_XB), GP(const bf16_t, WS_WIN), M, N, DM}; pg8::StaticOrder S; S.init(M, N, G, blk, WGM_MIN);
        pg8::EpiBf16P E{GP(bf16_t, WS_HB), N, GP(const float, WS_RS)};
        pg8::gemm_phase<pg8::EpiBf16P, pg8::StaticOrder, true, true, true, true>(lds, g, S, E);
    } else if constexpr (PH == PH_E2) {
        { constexpr int NP = BATCH * (NCH / 2) * 4;
          if (!(PROBE == 22 && DRY) && blk < NP) { GlaUC C; GlaUPre pre; f32x4 ua[16]; int ch = blk & 3; gla_u_consts(p, C, j, ch, otid()); gla_u_load(p, pre, blk >> 8, 2 * ((blk >> 2) & 63), ch, otid());
            for (int u = blk; u < NP; u += G) { const int u2 = u + G, b = u >> 8, n = 2 * ((u >> 2) & 63), h = u & 3; if (h != ch) { ch = h; gla_u_consts(p, C, j, ch, otid()); }
                for (int half = 0; half < 2; ++half) { const bool fst = half == 0;
                    gla_u_unit(p, C, b, n + half, h, lds, pre, fst || u2 < NP, fst ? b : u2 >> 8, fst ? n + 1 : 2 * ((u2 >> 2) & 63), fst ? h : u2 & 3, ua, fst); } } } }
        if (!(PROBE == 21 && DRY) && blk < BATCH * NCH * 8) { LruC C; LruPre pre; int chd = blk & 7; lru_local_consts(p, C, j, chd, otid()); lru_local_load(p, pre, blk >> 10, (blk >> 3) & 127, chd, otid());
            for (int u = blk; u < BATCH * NCH * 8; u += G) { const int u2 = u + G; if ((u & 7) != chd) { chd = u & 7; lru_local_consts(p, C, j, chd, otid()); }
                lru_local_unit(p, C, u >> 10, (u >> 3) & 127, u & 7, lds, pre, u2 < BATCH * NCH * 8, u2 >> 10, (u2 >> 3) & 127, u2 & 7); } }
    } else if constexpr (PH == PH_E3) {
        if (!(PROBE == 26 && DRY)) ph_gla_state(p, lds);
        if (!(PROBE == 25 && DRY)) for (int u = blk; u < BATCH * NCH / 2; u += G) lru_fix_unit(p, u >> 6, u & 63, lds);
    } else if constexpr (PH == PH_E4) {
        { TilesGLA pre; u32x2 sf[2][8]; constexpr int NP = BATCH * (NCH / 2) * 4;
          if (blk < NP) gla_out_load(p, pre, blk >> 8, 2 * ((blk >> 2) & 63), blk & 3, otid());
          for (int u = blk; u < NP; u += G) { const int u2 = u + G, b = u >> 8, n = 2 * ((u >> 2) & 63), h = u & 3;
              for (int half = 0; half < 2; ++half) { const bool fst = half == 0;
                  gla_out_unit(p, j, b, n + half, h, lds, pre, fst || u2 < NP, fst ? b : u2 >> 8, fst ? n + 1 : 2 * ((u2 >> 2) & 63), fst ? h : u2 & 3, sf, fst); } } }
        ph_weights_drain(p, l, 1, lds);
    } else if constexpr (PH == PH_O2) {
        for (int u = blk; u < BATCH * NCH; u += G) { const int b = u >> 7, n = u & 127;
            mlstm_tok_unit(p, j, b, n, lds);
            asm volatile("s_waitcnt vmcnt(0)" ::: "memory"); __syncthreads();
            MuPre pre; PoolPre ppre; mlstm_u_load(p, pre, b, n, 0, otid());
            for (int h = 0; h < 4; ++h) mlstm_u_unit(p, b, n, h, lds, pre, ppre);
            for (int g = 0; g < 4; ++g) pool_unit(p, j, b, n, g, lds, ppre); }
    } else if constexpr (PH == PH_O3) {
    } else if constexpr (PH == PH_O4) {
        ph_mlstm_state(p);
    } else if constexpr (PH == PH_O5) {
        { TilesML pre; if (blk < BATCH * NCH * 4) mlstm_out_load(p, pre, blk >> 9, (blk >> 2) & 127, blk & 3, otid());
          for (int u = blk; u < BATCH * NCH * 4; u += G) { const int u2 = u + G; mlstm_out_unit(p, j, u >> 9, (u >> 2) & 127, u & 3, lds, pre, u2 < BATCH * NCH * 4, u2 >> 9, (u2 >> 2) & 127, u2 & 3); } }
        ph_weights_drain(p, l, 1, lds);
    } else if constexpr (PH == PH_MOUT) {
        pg8::Gemm g{GP(const bf16_t, WS_U), GP(const bf16_t, WS_WOUT), M, DM, DM}; pg8::StaticOrder S; S.init(M, DM, G, blk, WGM_MOUT);
        pg8::EpiBf16P E{GP(bf16_t, WS_HO), DM, nullptr};
        pg8::gemm_phase<pg8::EpiBf16P, pg8::StaticOrder, true, true, true, true>(lds, g, S, E);
    } else if constexpr (PH == PH_MNORM) {
        ph_norm(GP(const bf16_t, WS_XB), GP(const bf16_t, WS_HO), 1.0f, ng + 3 * DM, DRY ? nullptr : GP(bf16_t, WS_XB), nullptr, GP(float, WS_RS));
    }
}


#define XB_TMO      128
#define XB_XCNT(j)  (256  + 64 * (j))
#define XB_XSUB(j)  (1280 + 64 * (j))
#define XB_XGEN(j)  (2304 + 64 * (j))
#define XB_TOP      3328
#define XB_TOPGEN   3392
#define XCD_BAR_WORDS 3456
#define XB_SPIN_CAP (1u << 18)

__device__ __forceinline__ unsigned xb_ld(unsigned* p)              { return __hip_atomic_load(p, __ATOMIC_RELAXED, __HIP_MEMORY_SCOPE_AGENT); }
__device__ __forceinline__ unsigned xb_add(unsigned* p, unsigned v) { return __hip_atomic_fetch_add(p, v, __ATOMIC_RELAXED, __HIP_MEMORY_SCOPE_AGENT); }
__device__ __forceinline__ unsigned xb_xcc_id() { return (unsigned)__builtin_amdgcn_s_getreg((3 << 11) | 20) & 0xFu; }
#define XB_SPIN(cond, bar) do { unsigned _sp = 0; while (cond) { __builtin_amdgcn_s_sleep(1); \
    if ((++_sp & 255u) == 0u) { if (xb_ld(&(bar)[XB_TMO])) break; if (_sp > XB_SPIN_CAP) { atomicAdd(&(bar)[XB_TMO], 1u); break; } } } } while (0)

struct XcdBarrier {
    unsigned* bar; unsigned x;
    volatile LAS unsigned* st;
};

__device__ __forceinline__ XcdBarrier xcd_barrier_post(unsigned* bar, volatile LAS unsigned* st) {
    XcdBarrier b; b.bar = bar; b.x = xb_xcc_id(); b.st = st;
    if (threadIdx.x == 0) (void)xb_add(&bar[XB_XCNT(b.x)], 1u);
    return b;
}
__device__ __forceinline__ void xcd_barrier_complete(unsigned* bar, unsigned x, unsigned& nloc, unsigned& nx) {
    const unsigned G = gridDim.x * gridDim.y * gridDim.z;
    unsigned sum, cnt, mine, sp = 0u;
    for (;;) {
        sum = 0u; cnt = 0u; mine = 0u;
#pragma unroll
        for (unsigned j = 0; j < 16; ++j) { const unsigned c = xb_ld(&bar[XB_XCNT(j)]); sum += c; cnt += (c > 0u) ? 1u : 0u; mine = (j == x) ? c : mine; }
        if (sum == G) break;
        __builtin_amdgcn_s_sleep(1);
        if ((++sp & 255u) == 0u) { if (xb_ld(&bar[XB_TMO])) break; if (sp > XB_SPIN_CAP) { atomicAdd(&bar[XB_TMO], 1u); break; } }
    }
    nloc = mine > 0u ? mine : 1u; nx = cnt > 0u ? cnt : 1u;
}

__device__ __forceinline__ void xcd_barrier(const XcdBarrier& b) {
    asm volatile("s_waitcnt vmcnt(0)" ::: "memory");
    __syncthreads();
    if (threadIdx.x == 0) {
        unsigned* bar = b.bar;
        __builtin_amdgcn_s_waitcnt(0);
        unsigned nloc = b.st[0], nx = b.st[1];
        if (nloc == 0u) { xcd_barrier_complete(bar, b.x, nloc, nx); b.st[0] = nloc; b.st[1] = nx; }
        const unsigned old = xb_add(&bar[XB_XSUB(b.x)], 1u);
        const unsigned gen = old / nloc;
        if (old + 1u == (gen + 1u) * nloc) {
            __builtin_amdgcn_fence(__ATOMIC_RELEASE, "agent");
            asm volatile("s_waitcnt vmcnt(0)" ::: "memory");
            const unsigned og = xb_add(&bar[XB_TOP], 1u);
            const unsigned tg = og / nx;
            if (og + 1u == (tg + 1u) * nx) xb_add(&bar[XB_TOPGEN], 1u);
            else XB_SPIN(xb_ld(&bar[XB_TOPGEN]) == tg, bar);
            __builtin_amdgcn_fence(__ATOMIC_ACQUIRE, "agent");
            xb_add(&bar[XB_XGEN(b.x)], 1u);
            asm volatile("s_waitcnt vmcnt(0)" ::: "memory");
        } else {
            XB_SPIN(xb_ld(&bar[XB_XGEN(b.x)]) == gen, bar);
            __builtin_amdgcn_fence(__ATOMIC_ACQUIRE, "agent");
            asm volatile("s_waitcnt vmcnt(0)" ::: "memory");
        }
    }
    __syncthreads();
}


__device__ __forceinline__ void xcd_barrier_fill(const XcdBarrier& b, const KP& p, int ql, int qpart, LAS unsigned char* lds) {
    asm volatile("s_waitcnt vmcnt(0)" ::: "memory");
    __syncthreads();
    if (threadIdx.x == 0) {
        unsigned* bar = b.bar;
        __builtin_amdgcn_s_waitcnt(0);
        unsigned nloc = b.st[0], nx = b.st[1];
        if (nloc == 0u) { xcd_barrier_complete(bar, b.x, nloc, nx); b.st[0] = nloc; b.st[1] = nx; }
        const unsigned old = xb_add(&bar[XB_XSUB(b.x)], 1u);
        const unsigned gen = old / nloc;
        if (old + 1u == (gen + 1u) * nloc) {
            __builtin_amdgcn_fence(__ATOMIC_RELEASE, "agent");
            asm volatile("s_waitcnt vmcnt(0)" ::: "memory");
            const unsigned og = xb_add(&bar[XB_TOP], 1u);
            const unsigned tg = og / nx;
            if (og + 1u == (tg + 1u) * nx) xb_add(&bar[XB_TOPGEN], 1u);
            else XB_SPIN(xb_ld(&bar[XB_TOPGEN]) == tg, bar);
            __builtin_amdgcn_fence(__ATOMIC_ACQUIRE, "agent");
            xb_add(&bar[XB_XGEN(b.x)], 1u);
            asm volatile("s_waitcnt vmcnt(0)" ::: "memory");
            b.st[2] = 0xFFFFFFFFu;
        } else b.st[2] = gen;
    }
    __syncthreads();
    const unsigned gen = b.st[2];
    if (gen != 0xFFFFFFFFu) {
        unsigned* xgen = &b.bar[XB_XGEN(b.x)];
        for (;;) {
            if ((unsigned)__builtin_amdgcn_readfirstlane((int)xb_ld(xgen)) != gen) break;
            if (!fill_step(p, ql, qpart, lds)) break;
        }
        if (threadIdx.x == 0) {
            XB_SPIN(xb_ld(xgen) == gen, b.bar);
            __builtin_amdgcn_fence(__ATOMIC_ACQUIRE, "agent");
            asm volatile("s_waitcnt vmcnt(0)" ::: "memory");
        }
    }
    __syncthreads();
}
constexpr int CW_BAR = 1024;
constexpr size_t CTL_ZERO_BYTES = 65536;
__global__ void __launch_bounds__(NTHREADS, 2) k_mega(KP p) {
    extern __shared__ __attribute__((aligned(16))) unsigned char smem[];
    LAS unsigned char* lds = (LAS unsigned char*)smem;
    volatile LAS unsigned* xbw = (volatile LAS unsigned*)(lds + LDS_BYTES - 16);
    if (threadIdx.x < 4) xbw[threadIdx.x] = 0u;
    __syncthreads();
    const XcdBarrier bar = xcd_barrier_post((unsigned*)(p.ws + WS_CTL) + CW_BAR, xbw);
#define PROBE_HIT(PH) ((PROBE == 1 && (PH == PH_FFN1 || PH == PH_FFN2 || PH == PH_MIN || PH == PH_MOUT)) || (PROBE == 2 && (PH == PH_INIT || PH == PH_FNORM || PH == PH_MNORM)) || \
    (PROBE == 3 && (PH == PH_E2 || PH == PH_E4 || PH == PH_O2 || PH == PH_O3 || PH == PH_O5)) || (PROBE == 4 && (PH == PH_E3 || PH == PH_O4)) || (PROBE == 5 && PH == PH_FFN1) || (PROBE == 6 && PH == PH_FFN2) || ((PROBE == 7 || PROBE == 21 || PROBE == 22) && PH == PH_E2) || (PROBE == 8 && PH == PH_E4) || (PROBE == 9 && PH == PH_O2) || ((PROBE == 10 || PROBE == 23 || PROBE == 24) && PH == PH_O3) || (PROBE == 11 && PH == PH_O5) || \
    (PROBE == 12 && PH == PH_MIN) || (PROBE == 13 && PH == PH_MOUT) || ((PROBE == 14 || PROBE == 18 || PROBE == 19) && PH == PH_INIT) || (PROBE == 15 && PH == PH_MNORM) || ((PROBE == 16 || PROBE == 25 || PROBE == 26) && PH == PH_E3) || (PROBE == 17 && PH == PH_O4))
#define xcd_barrier(b) do { XcdBarrier b_ = (b); asm volatile("" : "+s"(b_.x)); asm volatile("" : "+s"(b_.bar)); xcd_barrier(b_); if (PROBE == 20) xcd_barrier(b_); } while (0)
#define xcd_barrier_q(b, ql_, qp_) do { XcdBarrier b_ = (b); asm volatile("" : "+s"(b_.x)); asm volatile("" : "+s"(b_.bar)); xcd_barrier_fill(b_, p, ql_, qp_, lds); } while (0)
#define RUNP(PH, l_, s_) do { for (int rep_ = PROBE_HIT(PH) ? 0 : 1; rep_ < 2; ++rep_) { run_phase<PH>(p, l_, s_, lds, rep_ == 0); if (rep_ == 0) xcd_barrier(bar); } } while (0)
    RUNP(PH_INIT, 0, 0); xcd_barrier(bar);
    for (int l = 0; l < DEPTH; ++l) {
        for (int sub = 0; sub < 3; ++sub) {
            if (sub != 1) { const int s = sub >> 1;
                for (int hf = 0; hf < FFN_SPLIT; ++hf) {
                    RUNP(PH_FFN1, l, s + 2 * hf); xcd_barrier_q(bar, s == 0 ? l : l + 1, s == 0 ? 1 : 0);
                    RUNP(PH_FFN2, l, s + 2 * hf); xcd_barrier_q(bar, s == 0 ? l : l + 1, s == 0 ? 1 : 0);
                }
                RUNP(PH_FNORM, l, s); if (!(l == DEPTH - 1 && s == 1)) xcd_barrier(bar);
            } else {
                RUNP(PH_MIN, l, 0); xcd_barrier_q(bar, l, 1);
                if ((l & 1) == 0) {
                    RUNP(PH_E2, l, 0); xcd_barrier(bar);
                    RUNP(PH_E3, l, 0); xcd_barrier(bar);
                    RUNP(PH_E4, l, 0); xcd_barrier(bar);
                } else {
                    RUNP(PH_O2, l, 0); xcd_barrier(bar);
                    RUNP(PH_O4, l, 0); xcd_barrier(bar);
                    RUNP(PH_O5, l, 0); xcd_barrier(bar);
                }
                RUNP(PH_MOUT, l, 0); xcd_barrier_q(bar, l + 1, 0);
                RUNP(PH_MNORM, l, 0); xcd_barrier(bar);
            }
        }
    }
}

#ifndef MK_MULTI
#define MK_MULTI 0
#endif
template <int PH> __global__ void __launch_bounds__(NTHREADS, 2) k_phase(KP p, int l, int s) {
    extern __shared__ __attribute__((aligned(16))) unsigned char smem[];
    run_phase<PH>(p, l, s, (LAS unsigned char*)smem);
}

template <int PH> static void launch_phase(const KP& p, int l, int s, hipStream_t st) {
    static bool attr = false;
    if (!attr) { (void)hipFuncSetAttribute((const void*)k_phase<PH>, hipFuncAttributeMaxDynamicSharedMemorySize, LDS_BYTES); attr = true; }
    hipLaunchKernelGGL((k_phase<PH>), dim3(256), dim3(NTHREADS), LDS_BYTES, st, p, l, s);
}

extern "C" void kernel_launch(void* const* d_in, const int* in_sizes, int n_in, void* d_out, int out_size, void* d_ws, size_t ws_size, hipStream_t stream) {
    if (n_in != 30 || ws_size < WS_END) { fprintf(stderr, "kernel_launch: unexpected n_in %d or ws_size %zu (< %zu)\n", n_in, ws_size, (size_t)WS_END); return; }
    KP p{};
    for (int i = 0; i < 30; ++i) p.in[i] = (const float*)d_in[i];
    p.out = (float*)d_out; p.ws = (unsigned char*)d_ws;
#if MK_MULTI
    launch_phase<PH_INIT>(p, 0, 0, stream);
    for (int l = 0; l < DEPTH; ++l) {
        for (int hf = 0; hf < FFN_SPLIT; ++hf) { launch_phase<PH_FFN1>(p, l, 2 * hf, stream); launch_phase<PH_FFN2>(p, l, 2 * hf, stream); } launch_phase<PH_FNORM>(p, l, 0, stream);
        launch_phase<PH_MIN>(p, l, 0, stream);
        if ((l & 1) == 0) { launch_phase<PH_E2>(p, l, 0, stream); launch_phase<PH_E3>(p, l, 0, stream); launch_phase<PH_E4>(p, l, 0, stream); }
        else { launch_phase<PH_O2>(p, l, 0, stream); launch_phase<PH_O3>(p, l, 0, stream); launch_phase<PH_O4>(p, l, 0, stream); launch_phase<PH_O5>(p, l, 0, stream); }
        launch_phase<PH_MOUT>(p, l, 0, stream); launch_phase<PH_MNORM>(p, l, 0, stream);
        for (int hf = 0; hf < FFN_SPLIT; ++hf) { launch_phase<PH_FFN1>(p, l, 1 + 2 * hf, stream); launch_phase<PH_FFN2>(p, l, 1 + 2 * hf, stream); } launch_phase<PH_FNORM>(p, l, 1, stream);
    }
#else
    static int grid = 0;
    if (grid == 0) {
        int dev = 0, cus = 0, per_cu = 0;
        if (hipGetDevice(&dev) != hipSuccess || hipDeviceGetAttribute(&cus, hipDeviceAttributeMultiprocessorCount, dev) != hipSuccess) { fprintf(stderr, "kernel_launch: device query failed\n"); grid = -1; return; }
        if (hipFuncSetAttribute((const void*)k_mega, hipFuncAttributeMaxDynamicSharedMemorySize, LDS_BYTES) != hipSuccess) { fprintf(stderr, "kernel_launch: hipFuncSetAttribute failed\n"); grid = -1; return; }
        if (hipOccupancyMaxActiveBlocksPerMultiprocessor(&per_cu, (const void*)k_mega, NTHREADS, LDS_BYTES) != hipSuccess || per_cu < 1) { fprintf(stderr, "kernel_launch: occupancy query says %d blocks per CU\n", per_cu); per_cu = 1; }
        (void)hipGetLastError();
        grid = cus;
    }
    if (grid < 0) return;
    if (hipMemsetAsync((char*)d_ws + WS_CTL, 0, CTL_ZERO_BYTES, stream) != hipSuccess) { fprintf(stderr, "kernel_launch: memset failed\n"); return; }
    hipLaunchKernelGGL(k_mega, dim3(grid), dim3(NTHREADS), LDS_BYTES, stream, p);
#endif
}
```
